# Optimizing an MI355X kernel written in HIP

```python
import math
import jax, jax.numpy as jnp
from jax import lax
import numpy as np

D_MODEL = 1024
BATCH = 2
SEQ = 8192
DEPTH = 1
DEC_BATCH = 128
DEC_SEQ = 1
PAST_LEN = 8192
PAGE_SIZE = 128

DIL_GROUPS = ((128, 1), (512, 4), (2048, 16))
N_GROUPS = len(DIL_GROUPS)
HEADS_PER_GROUP = 4
ATT_HEADS = N_GROUPS * HEADS_PER_GROUP
ATT_HEAD_DIM = 64
ATT_WIDTH = ATT_HEADS * ATT_HEAD_DIM
ATT_OUT_WIDTH = HEADS_PER_GROUP * ATT_HEAD_DIM
ALIBI_EXP = 8.0

DN_HEADS = 4
DN_HEAD_DIM = 128
DN_WIDTH = DN_HEADS * DN_HEAD_DIM
DN_CONV = 4
DN_CHUNK = 64
DT_MIN = 1e-3
DT_MAX = 1e-1

D_FF = 2816
FFN_CONV = 3

DEEPNORM_ALPHA = (2 * DEPTH) ** 0.25
DEEPNORM_BETA = (8 * DEPTH) ** -0.25
LN_EPS = 1e-5
RMS_EPS = 1e-6

OFF_DN_QKV = 3 * ATT_WIDTH
OFF_DN_Z = OFF_DN_QKV + 3 * DN_WIDTH
OFF_DN_BETA = OFF_DN_Z + DN_WIDTH
OFF_DN_A = OFF_DN_BETA + DN_HEADS
OFF_GATE = OFF_DN_A + DN_HEADS
IN_WIDTH = OFF_GATE + 2 * D_MODEL

kernel_name = 'hybrid_dilated_attn_gated_deltanet_convffn_deepnorm_step'


def _layer_norm(x, g, b):
    xf = x.astype(jnp.float32)
    mu = jnp.mean(xf, axis=-1, keepdims=True)
    var = jnp.mean(jnp.square(xf - mu), axis=-1, keepdims=True)
    return ((xf - mu) * lax.rsqrt(var + LN_EPS) * g.astype(jnp.float32) + b.astype(jnp.float32)).astype(x.dtype)


def _l2norm(x):
    return x * lax.rsqrt(jnp.sum(jnp.square(x), axis=-1, keepdims=True) + RMS_EPS)


def _causal_dwconv(x, w, prev):
    width, t = w.shape[0], x.shape[1]
    xp = jnp.concatenate([prev.astype(x.dtype), x], axis=1)
    out = w[0] * xp[:, :t]
    for j in range(1, width):
        out = out + w[j] * xp[:, j:j + t]
    return out, xp[:, t:]


def _alibi_slopes():
    h = jnp.arange(1, ATT_HEADS + 1, dtype=jnp.float32)
    return jnp.exp2(-ALIBI_EXP * h / ATT_HEADS).reshape(N_GROUPS, HEADS_PER_GROUP)


def _dilated_prompt(q, k, v, window, dilation, slopes):
    b, t, h, e = q.shape
    steps = window // dilation
    n_sub = t // dilation
    n_blk = -(-n_sub // steps)
    pad = n_blk * steps - n_sub

    def to_blocks(a):
        a = a.reshape(b, n_sub, dilation, h, e).transpose(0, 2, 1, 3, 4)
        a = jnp.pad(a, ((0, 0), (0, 0), (0, pad), (0, 0), (0, 0)))
        return a.reshape(b, dilation, n_blk, steps, h, e)

    def with_prev(a):
        prev = jnp.pad(a[:, :, :-1], ((0, 0), (0, 0), (1, 0), (0, 0), (0, 0), (0, 0)))
        return jnp.concatenate([prev, a], axis=3)

    qb = to_blocks(q)
    kb = with_prev(to_blocks(k))
    vb = with_prev(to_blocks(v))
    s = jnp.einsum('brnqhe,brnkhe->brnhqk', qb, kb, preferred_element_type=jnp.float32) * (e ** -0.5)
    qi = jnp.arange(steps)[:, None]
    kj = jnp.arange(2 * steps)[None, :]
    dist = steps + qi - kj
    blk = jnp.arange(n_blk)[:, None, None]
    valid = (dist >= 0) & (dist <= steps) & ((blk > 0) | (kj >= steps))
    bias = -slopes[:, None, None] * (dilation * dist).astype(jnp.float32)
    s = jnp.where(valid[:, None], s + bias, -jnp.inf)
    m = jnp.max(s, axis=-1, keepdims=True)
    p = jnp.exp(s - m)
    l = jnp.sum(p, axis=-1, keepdims=True)
    o = jnp.einsum('brnhqk,brnkhe->brnqhe', (p / l).astype(v.dtype), vb, preferred_element_type=jnp.float32)
    lse = (m + jnp.log(l))[..., 0].transpose(0, 1, 2, 4, 3)

    def from_blocks(a):
        a = a.reshape(b, dilation, n_blk * steps, *a.shape[4:])[:, :, :n_sub]
        return jnp.swapaxes(a, 1, 2).reshape(b, t, *a.shape[3:])

    return from_blocks(o), from_blocks(lse)


def _dilated_step(q, k_ext, v_ext, n_past, window, dilation, slopes):
    b, s_new, h, e = q.shape
    steps = window // dilation
    back = jnp.arange(steps + 1)
    idx = n_past + jnp.arange(s_new)[:, None] - dilation * back[None, :]
    valid = idx >= 0
    idx = jnp.maximum(idx, 0)
    kg = jnp.take(k_ext, idx, axis=1)
    vg = jnp.take(v_ext, idx, axis=1)
    sc = jnp.einsum('bshe,bsihe->bshi', q, kg, preferred_element_type=jnp.float32) * (e ** -0.5)
    bias = -slopes[:, None] * (dilation * back).astype(jnp.float32)
    sc = jnp.where(valid[:, None, :], sc + bias, -jnp.inf)
    m = jnp.max(sc, axis=-1, keepdims=True)
    p = jnp.exp(sc - m)
    l = jnp.sum(p, axis=-1, keepdims=True)
    o = jnp.einsum('bshi,bsihe->bshe', (p / l).astype(v_ext.dtype), vg, preferred_element_type=jnp.float32)
    return o, (m + jnp.log(l))[..., 0]


def _combine_groups(outs, lses):
    w = jax.nn.softmax(jnp.stack(lses, axis=0), axis=0)
    return jnp.sum(w[..., None] * jnp.stack(outs, axis=0), axis=0)


def _delta_chunked(q, k, v, beta, g):
    b, t, h, dk = q.shape
    dv = v.shape[-1]
    c = DN_CHUNK
    nc = t // c

    def chunks(a):
        return a.reshape(b, nc, c, h, a.shape[-1]).transpose(1, 0, 3, 2, 4)

    qc, kc, vc = chunks(q), chunks(k), chunks(v)
    bc = chunks(beta[..., None])
    gcum = jnp.cumsum(chunks(g[..., None])[..., 0], axis=-1)
    tri = jnp.tril(jnp.ones((c, c), dtype=bool))
    tri_strict = jnp.tril(jnp.ones((c, c), dtype=bool), -1)
    decay = jnp.exp(jnp.where(tri, gcum[..., :, None] - gcum[..., None, :], -jnp.inf))
    kk = jnp.einsum('nbhid,nbhjd->nbhij', kc * bc, kc)
    lower = jnp.where(tri_strict, kk * decay, 0.0) + jnp.eye(c, dtype=jnp.float32)
    rhs = jnp.concatenate([vc * bc, kc * bc * jnp.exp(gcum)[..., None]], axis=-1)
    sol = lax.linalg.triangular_solve(lower, rhs, left_side=True, lower=True, unit_diagonal=True)
    u0, wk = sol[..., :dv], sol[..., dv:]
    attn = jnp.einsum('nbhid,nbhjd->nbhij', qc, kc) * decay
    q_dec = qc * jnp.exp(gcum)[..., None]
    k_dec = kc * jnp.exp(gcum[..., -1:] - gcum)[..., None]
    g_last = jnp.exp(gcum[..., -1])

    def step(s, xs):
        u0_, wk_, attn_, qd_, kd_, gl_ = xs
        u = u0_ - jnp.einsum('bhid,bhde->bhie', wk_, s)
        o = jnp.einsum('bhid,bhde->bhie', qd_, s) + jnp.einsum('bhij,bhje->bhie', attn_, u)
        s = s * gl_[..., None, None] + jnp.einsum('bhid,bhie->bhde', kd_, u)
        return s, o

    s0 = jnp.zeros((b, h, dk, dv), jnp.float32)
    s_fin, o = lax.scan(step, s0, (u0, wk, attn, q_dec, k_dec, g_last))
    return o.transpose(1, 0, 3, 2, 4).reshape(b, t, h, dv), s_fin


def _delta_recurrent(q, k, v, beta, g, s0):
    def step(s, xs):
        q_, k_, v_, b_, g_ = xs
        s = s * jnp.exp(g_)[..., None, None]
        u = b_[..., None] * (v_ - jnp.einsum('bhd,bhde->bhe', k_, s))
        s = s + jnp.einsum('bhd,bhe->bhde', k_, u)
        return s, jnp.einsum('bhd,bhde->bhe', q_, s)

    xs = (jnp.swapaxes(q, 0, 1), jnp.swapaxes(k, 0, 1), jnp.swapaxes(v, 0, 1),
          jnp.swapaxes(beta, 0, 1), jnp.swapaxes(g, 0, 1))
    s_fin, o = lax.scan(step, s0, xs)
    return jnp.swapaxes(o, 0, 1), s_fin


def _deltanet(qkv_pre, z, b_raw, a_raw, conv_prev, s_prev, w_conv, a_log, dt_bias, w_norm):
    bsz, t = qkv_pre.shape[:2]
    qkv, conv_new = _causal_dwconv(qkv_pre, w_conv, conv_prev)
    qkv = jax.nn.silu(qkv.astype(jnp.float32)).reshape(bsz, t, 3, DN_HEADS, DN_HEAD_DIM)
    q = _l2norm(qkv[:, :, 0]) * (DN_HEAD_DIM ** -0.5)
    k = _l2norm(qkv[:, :, 1])
    v = qkv[:, :, 2]
    beta = jax.nn.sigmoid(b_raw.astype(jnp.float32))
    g = -jnp.exp(a_log.astype(jnp.float32)) * jax.nn.softplus(a_raw.astype(jnp.float32) + dt_bias.astype(jnp.float32))
    if s_prev is None:
        o, s_new = _delta_chunked(q, k, v, beta, g)
    else:
        o, s_new = _delta_recurrent(q, k, v, beta, g, s_prev.astype(jnp.float32))
    zf = z.astype(jnp.float32).reshape(bsz, t, DN_HEADS, DN_HEAD_DIM)
    o = o * lax.rsqrt(jnp.mean(jnp.square(o), axis=-1, keepdims=True) + RMS_EPS) * w_norm.astype(jnp.float32) * jax.nn.silu(zf)
    return o.reshape(bsz, t, DN_WIDTH).astype(qkv_pre.dtype), conv_new, s_new.astype(qkv_pre.dtype)


def _conv_ffn(h, prev, w_up, w_conv, b_conv, w_down):
    up = h @ w_up
    a, gate = up[..., :D_FF], up[..., D_FF:]
    a_c, buf_new = _causal_dwconv(a, w_conv, prev)
    return (jax.nn.gelu(a_c + b_conv) * gate) @ w_down, buf_new


def _layer(x, kv_prev, dn_conv_prev, dn_s_prev, ffn_prev, lp):
    b, t, _ = x.shape
    prompt = kv_prev is None
    if prompt:
        dn_conv_prev = jnp.zeros((b, DN_CONV - 1, 3 * DN_WIDTH), x.dtype)
        ffn_prev = jnp.zeros((b, FFN_CONV - 1, D_FF), x.dtype)
    proj = x @ lp['w_in']

    qkv_a = proj[..., :OFF_DN_QKV].reshape(b, t, 3, N_GROUPS, HEADS_PER_GROUP, ATT_HEAD_DIM)
    slopes = _alibi_slopes()
    outs, lses, kv_new = [], [], []
    for gi, (window, dil) in enumerate(DIL_GROUPS):
        q, k, v = qkv_a[:, :, 0, gi], qkv_a[:, :, 1, gi], qkv_a[:, :, 2, gi]
        kv = jnp.stack([k, v], axis=2)
        if prompt:
            o, lse = _dilated_prompt(q, k, v, window, dil, slopes[gi])
            keep = min(window, t)
            kv_new.append(kv[:, t - keep:])
        else:
            n_past = kv_prev[gi].shape[1]
            kv_ext = jnp.concatenate([kv_prev[gi].astype(x.dtype), kv], axis=1)
            o, lse = _dilated_step(q, kv_ext[:, :, 0], kv_ext[:, :, 1], n_past, window, dil, slopes[gi])
            kv_new.append(kv_ext[:, -n_past:])
        outs.append(o)
        lses.append(lse)
    o_att = _combine_groups(outs, lses).reshape(b, t, ATT_OUT_WIDTH).astype(x.dtype)

    o_dn, dn_conv_new, dn_s_new = _deltanet(
        proj[..., OFF_DN_QKV:OFF_DN_Z], proj[..., OFF_DN_Z:OFF_DN_BETA],
        proj[..., OFF_DN_BETA:OFF_DN_A], proj[..., OFF_DN_A:OFF_GATE],
        dn_conv_prev, dn_s_prev, lp['w_dn_conv'], lp['dn_a_log'], lp['dn_dt_bias'], lp['dn_onorm_w'])

    gate = jax.nn.sigmoid(proj[..., OFF_GATE:].astype(jnp.float32))
    merged = gate[..., :D_MODEL] * (o_att @ lp['w_att_out']) + gate[..., D_MODEL:] * (o_dn @ lp['w_dn_out'])
    mix = merged.astype(x.dtype) @ lp['w_o']
    h = _layer_norm(DEEPNORM_ALPHA * x + mix, lp['ln1_g'], lp['ln1_b'])

    f, ffn_new = _conv_ffn(h, ffn_prev, lp['w_up'], lp['w_ffn_conv'], lp['b_ffn_conv'], lp['w_down'])
    y = _layer_norm(DEEPNORM_ALPHA * h + f, lp['ln2_g'], lp['ln2_b'])
    return y, (kv_new[0], kv_new[1], kv_new[2], dn_conv_new, dn_s_new, ffn_new)


def setup_inputs(seed: int = 0) -> dict:
    key = jax.random.key(seed)
    ks = jax.random.split(key, 24)
    f32 = jnp.float32

    def nrm(k, shape, scale):
        return jax.random.normal(k, shape, f32) * scale

    lw = [min(w, PAST_LEN) for w, _ in DIL_GROUPS]

    def kv_shape(n):
        return (DEPTH, DEC_BATCH, n, 2, HEADS_PER_GROUP, ATT_HEAD_DIM)

    dt = jnp.exp(jax.random.uniform(ks[11], (DEPTH, DN_HEADS), f32, math.log(DT_MIN), math.log(DT_MAX)))
    return {
        'x_prompt': nrm(ks[0], (BATCH, SEQ, D_MODEL), 1.0),
        'x_sample': nrm(ks[1], (DEC_BATCH, DEC_SEQ, D_MODEL), 1.0),
        'cache_kv_w128': nrm(ks[2], kv_shape(lw[0]), 1.0),
        'cache_kv_w512': nrm(ks[3], kv_shape(lw[1]), 1.0),
        'cache_kv_w2048': nrm(ks[4], kv_shape(lw[2]), 1.0),
        'state_dn_conv': nrm(ks[5], (DEPTH, DEC_BATCH, DN_CONV - 1, 3 * DN_WIDTH), 1.0),
        'state_dn_S': nrm(ks[6], (DEPTH, DEC_BATCH, DN_HEADS, DN_HEAD_DIM, DN_HEAD_DIM), 0.3),
        'state_ffn_conv': nrm(ks[7], (DEPTH, DEC_BATCH, FFN_CONV - 1, D_FF), 1.0),
        'w_in': nrm(ks[8], (DEPTH, D_MODEL, IN_WIDTH), D_MODEL ** -0.5),
        'w_dn_conv': nrm(ks[9], (DEPTH, DN_CONV, 3 * DN_WIDTH), DN_CONV ** -0.5),
        'dn_a_log': jnp.log(jax.random.uniform(ks[10], (DEPTH, DN_HEADS), f32, 1.0, 16.0)),
        'dn_dt_bias': dt + jnp.log(-jnp.expm1(-dt)),
        'dn_onorm_w': 1.0 + nrm(ks[12], (DEPTH, DN_HEAD_DIM), 0.02),
        'w_att_out': nrm(ks[13], (DEPTH, ATT_OUT_WIDTH, D_MODEL), ATT_OUT_WIDTH ** -0.5 * DEEPNORM_BETA),
        'w_dn_out': nrm(ks[14], (DEPTH, DN_WIDTH, D_MODEL), DN_WIDTH ** -0.5 * DEEPNORM_BETA),
        'w_o': nrm(ks[15], (DEPTH, D_MODEL, D_MODEL), D_MODEL ** -0.5 * DEEPNORM_BETA),
        'ln1_g': 1.0 + nrm(ks[16], (DEPTH, D_MODEL), 0.02),
        'ln1_b': nrm(ks[17], (DEPTH, D_MODEL), 0.02),
        'w_up': nrm(ks[18], (DEPTH, D_MODEL, 2 * D_FF), D_MODEL ** -0.5),
        'w_ffn_conv': nrm(ks[19], (DEPTH, FFN_CONV, D_FF), FFN_CONV ** -0.5),
        'b_ffn_conv': nrm(ks[20], (DEPTH, D_FF), 0.02),
        'w_down': nrm(ks[21], (DEPTH, D_FF, D_MODEL), D_FF ** -0.5 * DEEPNORM_BETA),
        'ln2_g': 1.0 + nrm(ks[22], (DEPTH, D_MODEL), 0.02),
        'ln2_b': nrm(ks[23], (DEPTH, D_MODEL), 0.02),
    }


def reference(x_prompt, x_sample, cache_kv_w128, cache_kv_w512, cache_kv_w2048, state_dn_conv,
              state_dn_S, state_ffn_conv, w_in, w_dn_conv, dn_a_log, dn_dt_bias, dn_onorm_w,
              w_att_out, w_dn_out, w_o, ln1_g, ln1_b, w_up, w_ffn_conv, b_ffn_conv, w_down,
              ln2_g, ln2_b):
    def layer_params(l):
        return {'w_in': w_in[l], 'w_dn_conv': w_dn_conv[l], 'dn_a_log': dn_a_log[l],
                'dn_dt_bias': dn_dt_bias[l], 'dn_onorm_w': dn_onorm_w[l], 'w_att_out': w_att_out[l],
                'w_dn_out': w_dn_out[l], 'w_o': w_o[l], 'ln1_g': ln1_g[l], 'ln1_b': ln1_b[l],
                'w_up': w_up[l], 'w_ffn_conv': w_ffn_conv[l], 'b_ffn_conv': b_ffn_conv[l],
                'w_down': w_down[l], 'ln2_g': ln2_g[l], 'ln2_b': ln2_b[l]}

    yp, ys = x_prompt, x_sample
    p_states, s_states = [], []
    for l in range(DEPTH):
        lp = layer_params(l)
        yp, st_p = _layer(yp, None, None, None, None, lp)
        p_states.append(st_p)
        ys, st_s = _layer(ys, (cache_kv_w128[l], cache_kv_w512[l], cache_kv_w2048[l]),
                          state_dn_conv[l], state_dn_S[l], state_ffn_conv[l], lp)
        s_states.append(st_s)

    def stacked(states, i):
        return jnp.stack([st[i] for st in states], axis=0)

    return (yp, ys,
            stacked(p_states, 0), stacked(p_states, 1), stacked(p_states, 2),
            stacked(p_states, 3), stacked(p_states, 4), stacked(p_states, 5),
            stacked(s_states, 0), stacked(s_states, 1), stacked(s_states, 2),
            stacked(s_states, 3), stacked(s_states, 4), stacked(s_states, 5))
```

```cpp
#include <hip/hip_runtime.h>
#include <hip/hip_cooperative_groups.h>
#include <cstdio>
namespace cg = cooperative_groups;

#define LAS __attribute__((address_space(3)))
typedef LAS unsigned char lds_t;
typedef unsigned short bf16_t;
typedef short bf16x8 __attribute__((ext_vector_type(8)));
typedef float f32x4 __attribute__((ext_vector_type(4)));
typedef unsigned u32x4 __attribute__((ext_vector_type(4)));
typedef unsigned u32x2 __attribute__((ext_vector_type(2)));

constexpr int T_SEQ = 8192, NPROMPT = 16384, NSAMP = 128, MROWS = 16512, MPAD = 16640;
constexpr int DM = 1024, NPROJ = 6400, INW = 6408, DFF = 2816, NUP = 5632;
constexpr int C_AK = 768, C_AV = 1536, C_DN = 2304, C_Z = 3840, C_GA = 4352, C_GD = 5376;
constexpr float ALPHA = 1.189207115002721f;
constexpr int LDS_BYTES = 155648;
constexpr int NTHR = 512;

constexpr size_t O_Y = 0, O_YS = 16777216, O_PKV0 = O_YS + 131072, O_PKV1 = O_PKV0 + 131072, O_PKV2 = O_PKV1 + 524288,
                 O_PDC = O_PKV2 + 2097152, O_PDS = O_PDC + 9216, O_PFC = O_PDS + 131072, O_SKV0 = O_PFC + 11264,
                 O_SKV1 = O_SKV0 + 8388608, O_SKV2 = O_SKV1 + 33554432, O_SDC = O_SKV2 + 134217728, O_SDS = O_SDC + 589824,
                 O_SFC = O_SDS + 8388608, O_END = O_SFC + 720896;

constexpr size_t al256(size_t x) { return (x + 255) & ~(size_t)255; }
constexpr size_t W_CTL = 0;
constexpr size_t W_XB = 16384;
constexpr size_t W_WIN = W_XB + al256((size_t)MPAD * DM * 2);
constexpr size_t W_WAO = W_WIN + al256((size_t)NPROJ * DM * 2);
constexpr size_t W_WDO = W_WAO + al256((size_t)DM * 256 * 2);
constexpr size_t W_WO = W_WDO + al256((size_t)DM * 512 * 2);
constexpr size_t W_WUP = W_WO + al256((size_t)DM * DM * 2);
constexpr size_t W_WDN = W_WUP + al256((size_t)NUP * DM * 2);
constexpr size_t W_AB = W_WDN + al256((size_t)DM * DFF * 2);
constexpr size_t W_PROJ = W_AB + al256((size_t)MROWS * 8 * 4);
constexpr size_t W_OG = W_PROJ + al256((size_t)MPAD * NPROJ * 2);
constexpr size_t W_LSE = W_OG + al256((size_t)3 * NPROMPT * 256 * 4);
constexpr size_t W_OATT = W_LSE + al256((size_t)3 * NPROMPT * 4 * 4);
constexpr size_t W_ODN = W_OATT + al256((size_t)MPAD * 256 * 2);
constexpr size_t TASK_BYTES = 90368;
constexpr size_t W_DNT = W_ODN + al256((size_t)MPAD * 512 * 2);
constexpr size_t W_GL = W_DNT + al256((size_t)1024 * TASK_BYTES);
constexpr size_t W_T1 = W_GL + al256(1024 * 4);
constexpr size_t W_MRG = W_T1 + al256((size_t)MPAD * DM * 4);
constexpr size_t W_PRE = W_MRG + al256((size_t)MPAD * DM * 2);
constexpr size_t W_H = W_PRE + al256((size_t)MPAD * DM * 4);
constexpr size_t W_HB = W_H + al256((size_t)MPAD * DM * 4);
constexpr size_t W_UP = W_HB + al256((size_t)MPAD * DM * 2);
constexpr size_t W_ACT = W_UP + al256((size_t)MPAD * NUP * 2);
constexpr size_t W_OSC = W_ACT + al256((size_t)MPAD * DFF * 2);
constexpr size_t W_END = W_OSC + al256((size_t)1024 * 32768);

struct Params {
    const float* in[24];
    float* out;
    unsigned char* ws;
};

__device__ __forceinline__ float bf2f(bf16_t b) { return __uint_as_float(((unsigned)b) << 16); }
__device__ __forceinline__ bf16_t f2bf(float f) { unsigned u = __float_as_uint(f); u += 0x7FFFu + ((u >> 16) & 1u); return (bf16_t)(u >> 16); }
__device__ __forceinline__ unsigned pk2(float lo, float hi) { unsigned r; asm("v_cvt_pk_bf16_f32 %0, %1, %2" : "=v"(r) : "v"(lo), "v"(hi)); return r; }
__device__ __forceinline__ float sigmoidf_(float x) { return 1.0f / (1.0f + __expf(-x)); }
__device__ __forceinline__ float siluf_(float x) { return x / (1.0f + __expf(-x)); }
__device__ __forceinline__ float softplusf_(float x) { return x > 20.0f ? x : log1pf(__expf(x)); }
__device__ __forceinline__ float gelu_tanh(float x) { const float u = 0.7978845608028654f * (x + 0.044715f * x * x * x); return x / (1.0f + __expf(-2.0f * u)); }
__device__ __forceinline__ float wave_sum(float v) {
#pragma unroll
    for (int o = 32; o > 0; o >>= 1) v += __shfl_xor(v, o, 64);
    return v;
}
__device__ __forceinline__ float wave_max(float v) {
#pragma unroll
    for (int o = 32; o > 0; o >>= 1) v = fmaxf(v, __shfl_xor(v, o, 64));
    return v;
}
__device__ __forceinline__ float sum16(float v) {
#pragma unroll
    for (int o = 8; o > 0; o >>= 1) v += __shfl_xor(v, o, 64);
    return v;
}
__device__ __forceinline__ f32x4 bf4_to_f4(u32x2 w) {
    f32x4 r; r[0] = __uint_as_float(w[0] << 16); r[1] = __uint_as_float(w[0] & 0xFFFF0000u); r[2] = __uint_as_float(w[1] << 16); r[3] = __uint_as_float(w[1] & 0xFFFF0000u); return r;
}
#define WSYNC() do { asm volatile("" ::: "memory"); __builtin_amdgcn_wave_barrier(); asm volatile("" ::: "memory"); } while (0)
__device__ __forceinline__ int opaque_tid() { int t = threadIdx.x; asm volatile("" : "+v"(t)); return t; }
__device__ __forceinline__ f32x4 mfma16(bf16x8 a, bf16x8 b, f32x4 c) { return __builtin_amdgcn_mfma_f32_16x16x32_bf16(a, b, c, 0, 0, 0); }

namespace pg8 {
constexpr int BM = 256, BK = 64, HALF = 128, HTB = HALF * BK * 2, STAGE_BYTES = 8 * HTB, NXCD = 8, WGM = 8;
__device__ __forceinline__ int lds_byte(int r, int c) { const int st = (r >> 4) * 2 + (c >> 5), rr = r & 15, cc = c & 31, ob = rr * 64 + cc * 2; return st * 1024 + (ob ^ (((ob >> 9) & 1) << 5)); }
__device__ __forceinline__ void stage_rc(int b, int& R, int& C) { const int st = b / 1024, sb = b % 1024, swz = sb ^ (((sb >> 9) & 1) << 5); R = (st >> 1) * 16 + swz / 64; C = (st & 1) * 32 + (swz % 64) / 2; }
__device__ __forceinline__ int perm32(int rho) { const int n = rho >> 4, i = rho & 15; return 8 * (i >> 2) + 4 * n + (i & 3); }
struct Unit { int pm, pn; };
struct Gemm { const bf16_t* A; const bf16_t* Bt; int M, N, K; int ld = 0, ncol = 0; };
struct StaticOrder {
    int nM, nN, nwg, G, c;
    __device__ __forceinline__ void init(int M, int N, int G_, int c_) { nM = M / BM; nN = N / BM; nwg = nM * nN; G = G_; c = c_; }
    __device__ __forceinline__ bool next(int i, Unit& u) const {
        const long L = (long)i * G + c; if (L >= nwg) return false;
        int wgid = (int)L; { const int q = nwg / NXCD, r = nwg % NXCD, xcd = wgid % NXCD, off = wgid / NXCD; wgid = (xcd < r ? xcd * (q + 1) : r * (q + 1) + (xcd - r) * q) + off; }
        const int nig = WGM * nN, gid = wgid / nig, fm = gid * WGM, gsz = (nM - fm) < WGM ? (nM - fm) : WGM;
        u.pm = fm + ((wgid % nig) % gsz); u.pn = (wgid % nig) / gsz; return true;
    }
};
__device__ __forceinline__ unsigned cvt_pk_bf16(float lo, float hi) { unsigned r; asm volatile("v_cvt_pk_bf16_f32 %0, %1, %2" : "=v"(r) : "v"(lo), "v"(hi)); return r; }

template <class Epi>
__device__ __forceinline__ void gemm_phase(lds_t* lds, const Gemm g, const StaticOrder& S, const Epi& E) {
    const int tid = opaque_tid(), wid = __builtin_amdgcn_readfirstlane(tid >> 6), lane = tid & 63, wr = wid >> 2, wc = wid & 3, fr = lane & 15, fq = lane >> 4;
    const int K = g.K, nt = K / BK, ld = g.ld ? g.ld : g.K, ncol = g.ncol;
    unsigned voffA[2], voffB[2];
#pragma unroll
    for (int i = 0; i < 2; ++i) { int R, C; stage_rc(tid * 16 + i * 8192, R, C); const int Rb = Epi::PERM ? ((R & ~31) + perm32(R & 31)) : R;
        voffA[i] = (unsigned)(R * ld + C) * 2u; voffB[i] = (unsigned)(Rb * ld + C) * 2u; }
    const size_t kstep = (size_t)(BK * 2);
    const size_t hstep = (size_t)HALF * ld * 2;
    const size_t tstep = 2 * hstep;
    const unsigned ldsw = (unsigned)wid * 1024u;
    const int aoff = lds_byte(wr * 64 + fr, fq * 8), boff = lds_byte(wc * 32 + fr, fq * 8);
#define PG8_SA(b, h) (((b) * 2 + (h)) * HTB)
#define PG8_SB(b, h) ((4 + (b) * 2 + (h)) * HTB)
#define PG8_STAGE(bufoff, gbase, voff) do { _Pragma("unroll") for (int _i = 0; _i < 2; ++_i) \
        __builtin_amdgcn_global_load_lds((const unsigned*)((const char*)(gbase) + (voff)[_i]), (LAS unsigned*)(lds + (bufoff) + ldsw + _i * 8192), 16, 0, 0); } while (0)
#define PG8_LDA(dst, b, h) do { _Pragma("unroll") for (int m = 0; m < 4; ++m) _Pragma("unroll") for (int k = 0; k < 2; ++k) dst[m][k] = *(const LAS bf16x8*)(lds + PG8_SA(b, h) + aoff + m * 2048 + k * 1024); } while (0)
#define PG8_LDB(dst, b, h) do { _Pragma("unroll") for (int n = 0; n < 2; ++n) _Pragma("unroll") for (int k = 0; k < 2; ++k) dst[n][k] = *(const LAS bf16x8*)(lds + PG8_SB(b, h) + boff + n * 2048 + k * 1024); } while (0)
#define PG8_MMA(ai, bj, At, Bt) do { __builtin_amdgcn_s_setprio(1); _Pragma("unroll") for (int m = 0; m < 4; ++m) _Pragma("unroll") for (int n = 0; n < 2; ++n) _Pragma("unroll") for (int k = 0; k < 2; ++k) \
        acc[ai][bj][m][n] = __builtin_amdgcn_mfma_f32_16x16x32_bf16(Bt[n][k], At[m][k], acc[ai][bj][m][n], 0, 0, 0); __builtin_amdgcn_s_setprio(0); } while (0)
#define PG8_WAIT_V(n) asm volatile("s_waitcnt vmcnt(" #n ")" ::: "memory")
#define PG8_WAIT_L(n) asm volatile("s_waitcnt lgkmcnt(" #n ")" ::: "memory")
#define PG8_BAR __builtin_amdgcn_s_barrier()
#define PG8_SCHED __builtin_amdgcn_sched_barrier(0)
    Unit cur, nxt; int ui = 0;
    if (!S.next(0, cur)) return;
    f32x4 acc[2][2][4][2];
#pragma unroll
    for (int a = 0; a < 2; ++a)
#pragma unroll
        for (int b = 0; b < 2; ++b)
#pragma unroll
            for (int m = 0; m < 4; ++m)
#pragma unroll
                for (int n = 0; n < 2; ++n) acc[a][b][m][n] = (f32x4){0.f, 0.f, 0.f, 0.f};
    bf16x8 At[4][2], B0[2][2], B1[2][2];
#define PG8_ABASE(u) ((const char*)g.A + (size_t)(u).pm * tstep + (ncol ? (size_t)((u).pn / ncol) * K * 2 : (size_t)0))
#define PG8_BBASE(u) ((const char*)g.Bt + (ncol ? (size_t)((u).pn % ncol) * tstep + (size_t)((u).pn / ncol) * K * 2 : (size_t)(u).pn * tstep))
    const char* cA = PG8_ABASE(cur); const char* cB = PG8_BBASE(cur);
    PG8_STAGE(PG8_SB(0, 0), cB, voffB); PG8_STAGE(PG8_SA(0, 0), cA, voffA); PG8_STAGE(PG8_SB(0, 1), cB + hstep, voffB); PG8_STAGE(PG8_SA(0, 1), cA + hstep, voffA);
    if (wr == 1) PG8_BAR;
    PG8_WAIT_V(4); PG8_BAR;
    PG8_STAGE(PG8_SB(1, 0), cB + kstep, voffB); PG8_STAGE(PG8_SA(1, 0), cA + kstep, voffA); PG8_STAGE(PG8_SB(1, 1), cB + hstep + kstep, voffB);
    PG8_WAIT_V(6); PG8_BAR;
    for (;;) {
        const bool has_next = S.next(ui + 1, nxt);
        const char* nA = has_next ? PG8_ABASE(nxt) : cA; const char* nB = has_next ? PG8_BBASE(nxt) : cB;
        for (int t = 0; t < nt; t += 2) {
            const bool last = (t == nt - 2);
            const char* a1 = cA + (size_t)(t + 1) * kstep;
            const char* a2 = last ? nA : cA + (size_t)(t + 2) * kstep; const char* b2 = last ? nB : cB + (size_t)(t + 2) * kstep;
            const char* a3 = a2 + kstep; const char* b3 = b2 + kstep;
            PG8_LDB(B0, 0, 0); PG8_SCHED; PG8_LDA(At, 0, 0); PG8_STAGE(PG8_SA(1, 1), a1 + hstep, voffA);
            PG8_WAIT_L(8); PG8_BAR; PG8_WAIT_L(0); PG8_MMA(0, 0, At, B0); PG8_BAR; PG8_SCHED;
            PG8_LDB(B1, 0, 1); PG8_STAGE(PG8_SB(0, 0), b2, voffB);
            PG8_BAR; PG8_WAIT_L(0); PG8_MMA(0, 1, At, B1); PG8_BAR;
            PG8_LDA(At, 0, 1); PG8_STAGE(PG8_SA(0, 0), a2, voffA);
            PG8_BAR; PG8_WAIT_L(0); PG8_MMA(1, 0, At, B0); PG8_BAR; PG8_SCHED;
            PG8_STAGE(PG8_SB(0, 1), b2 + hstep, voffB);
            PG8_WAIT_V(6); PG8_BAR; PG8_MMA(1, 1, At, B1); PG8_BAR;
            PG8_LDB(B0, 1, 0); PG8_SCHED; PG8_LDA(At, 1, 0); PG8_STAGE(PG8_SA(0, 1), a2 + hstep, voffA);
            PG8_WAIT_L(8); PG8_BAR; PG8_WAIT_L(0); PG8_MMA(0, 0, At, B0); PG8_BAR; PG8_SCHED;
            PG8_LDB(B1, 1, 1); PG8_STAGE(PG8_SB(1, 0), b3, voffB);
            PG8_BAR; PG8_WAIT_L(0); PG8_MMA(0, 1, At, B1); PG8_BAR;
            PG8_LDA(At, 1, 1); PG8_STAGE(PG8_SA(1, 0), a3, voffA);
            PG8_BAR; PG8_WAIT_L(0); PG8_MMA(1, 0, At, B0); PG8_BAR; PG8_SCHED;
            PG8_STAGE(PG8_SB(1, 1), b3 + hstep, voffB);
            PG8_WAIT_V(6); PG8_BAR; PG8_MMA(1, 1, At, B1); PG8_BAR;
        }
        E(acc, cur, wr, wc, fr, fq);
        if (!has_next) break;
#pragma unroll
        for (int a = 0; a < 2; ++a)
#pragma unroll
            for (int b = 0; b < 2; ++b)
#pragma unroll
                for (int m = 0; m < 4; ++m)
#pragma unroll
                    for (int n = 0; n < 2; ++n) acc[a][b][m][n] = (f32x4){0.f, 0.f, 0.f, 0.f};
        cur = nxt; cA = nA; cB = nB; ++ui;
    }
    PG8_WAIT_V(0);
    if (wr == 0) PG8_BAR;
    PG8_BAR;
#undef PG8_ABASE
#undef PG8_BBASE
#undef PG8_SA
#undef PG8_SB
#undef PG8_STAGE
#undef PG8_LDA
#undef PG8_LDB
#undef PG8_MMA
#undef PG8_WAIT_V
#undef PG8_WAIT_L
#undef PG8_BAR
#undef PG8_SCHED
}

struct EpiStoreBf16 {
    static constexpr bool PERM = true;
    bf16_t* O; int ldc;
    __device__ __forceinline__ void operator()(const f32x4 (&acc)[2][2][4][2], const Unit& u, int wr, int wc, int fr, int fq) const {
        const int row0 = u.pm * BM + wr * 64 + fr, col0 = u.pn * BM + wc * 32 + 8 * fq;
#pragma unroll
        for (int ai = 0; ai < 2; ++ai)
#pragma unroll
            for (int m = 0; m < 4; ++m) { bf16_t* rowp = O + (size_t)(row0 + ai * HALF + m * 16) * ldc + col0;
#pragma unroll
                for (int bj = 0; bj < 2; ++bj) { const f32x4 v0 = acc[ai][bj][m][0], v1 = acc[ai][bj][m][1];
                    u32x4 w; w.x = cvt_pk_bf16(v0[0], v0[1]); w.y = cvt_pk_bf16(v0[2], v0[3]); w.z = cvt_pk_bf16(v1[0], v1[1]); w.w = cvt_pk_bf16(v1[2], v1[3]);
                    *(u32x4*)(rowp + bj * HALF) = w; } }
    }
};
struct EpiGate1 {
    static constexpr bool PERM = false;
    float* T1; const bf16_t* PROJ;
    __device__ __forceinline__ void operator()(const f32x4 (&acc)[2][2][4][2], const Unit& u, int wr, int wc, int fr, int fq) const {
        const int row0 = u.pm * BM + wr * 64 + fr, col0 = u.pn * BM + wc * 32 + 4 * fq;
#pragma unroll
        for (int m = 0; m < 4; ++m) {
            u32x2 gt[2][2][2];
#pragma unroll
            for (int ai = 0; ai < 2; ++ai)
#pragma unroll
                for (int bj = 0; bj < 2; ++bj)
#pragma unroll
                    for (int n = 0; n < 2; ++n) gt[ai][bj][n] = *(const u32x2*)(PROJ + (size_t)(row0 + ai * HALF + m * 16) * NPROJ + C_GA + col0 + bj * HALF + n * 16);
#pragma unroll
            for (int ai = 0; ai < 2; ++ai)
#pragma unroll
                for (int bj = 0; bj < 2; ++bj)
#pragma unroll
                    for (int n = 0; n < 2; ++n) { const f32x4 g = bf4_to_f4(gt[ai][bj][n]); const f32x4 a = acc[ai][bj][m][n]; f32x4 o;
#pragma unroll
                        for (int j = 0; j < 4; ++j) o[j] = a[j] * sigmoidf_(g[j]);
                        *(f32x4*)(T1 + (size_t)(row0 + ai * HALF + m * 16) * DM + col0 + bj * HALF + n * 16) = o; }
        }
    }
};
struct EpiGate2 {
    static constexpr bool PERM = false;
    bf16_t* MRG; const float* T1; const bf16_t* PROJ;
    __device__ __forceinline__ void operator()(const f32x4 (&acc)[2][2][4][2], const Unit& u, int wr, int wc, int fr, int fq) const {
        const int row0 = u.pm * BM + wr * 64 + fr, col0 = u.pn * BM + wc * 32 + 4 * fq;
#pragma unroll
        for (int m = 0; m < 4; ++m) {
            u32x2 gt[2][2][2]; f32x4 t1[2][2][2];
#pragma unroll
            for (int ai = 0; ai < 2; ++ai)
#pragma unroll
                for (int bj = 0; bj < 2; ++bj)
#pragma unroll
                    for (int n = 0; n < 2; ++n) { const size_t row = (size_t)(row0 + ai * HALF + m * 16); const int col = col0 + bj * HALF + n * 16;
                        gt[ai][bj][n] = *(const u32x2*)(PROJ + row * NPROJ + C_GD + col); t1[ai][bj][n] = *(const f32x4*)(T1 + row * DM + col); }
#pragma unroll
            for (int ai = 0; ai < 2; ++ai)
#pragma unroll
                for (int bj = 0; bj < 2; ++bj)
#pragma unroll
                    for (int n = 0; n < 2; ++n) { const f32x4 g = bf4_to_f4(gt[ai][bj][n]); const f32x4 a = acc[ai][bj][m][n]; f32x4 o;
#pragma unroll
                        for (int j = 0; j < 4; ++j) o[j] = t1[ai][bj][n][j] + a[j] * sigmoidf_(g[j]);
                        u32x2 w; w[0] = cvt_pk_bf16(o[0], o[1]); w[1] = cvt_pk_bf16(o[2], o[3]);
                        *(u32x2*)(MRG + (size_t)(row0 + ai * HALF + m * 16) * DM + col0 + bj * HALF + n * 16) = w; }
        }
    }
};
struct EpiRes {
    static constexpr bool PERM = false;
    float* PRE; const float* resA; const float* resB;
    __device__ __forceinline__ void operator()(const f32x4 (&acc)[2][2][4][2], const Unit& u, int wr, int wc, int fr, int fq) const {
        const int row0 = u.pm * BM + wr * 64 + fr, col0 = u.pn * BM + wc * 32 + 4 * fq;
#pragma unroll
        for (int m = 0; m < 4; ++m) {
            f32x4 rv[2][2][2];
#pragma unroll
            for (int ai = 0; ai < 2; ++ai) { const int row = row0 + ai * HALF + m * 16; const int rc = row < MROWS ? row : 0;
                const float* rp = rc < NPROMPT ? resA + (size_t)rc * DM : resB + (size_t)(rc - NPROMPT) * DM;
#pragma unroll
                for (int bj = 0; bj < 2; ++bj)
#pragma unroll
                    for (int n = 0; n < 2; ++n) rv[ai][bj][n] = *(const f32x4*)(rp + col0 + bj * HALF + n * 16); }
#pragma unroll
            for (int ai = 0; ai < 2; ++ai) { const int row = row0 + ai * HALF + m * 16;
                if (row < MROWS) {
#pragma unroll
                    for (int bj = 0; bj < 2; ++bj)
#pragma unroll
                        for (int n = 0; n < 2; ++n) { const f32x4 a = acc[ai][bj][m][n]; f32x4 o;
#pragma unroll
                            for (int j = 0; j < 4; ++j) o[j] = ALPHA * rv[ai][bj][n][j] + a[j];
                            *(f32x4*)(PRE + (size_t)row * DM + col0 + bj * HALF + n * 16) = o; } } }
        }
    }
};
struct EpiAtomic {
    static constexpr bool PERM = false;
    float* PRE; int row_base, ncol;
    __device__ __forceinline__ void operator()(const f32x4 (&acc)[2][2][4][2], const Unit& u, int wr, int wc, int fr, int fq) const {
        const int row0 = row_base + u.pm * BM + wr * 64 + fr, col0 = (u.pn % ncol) * BM + wc * 32 + 4 * fq;
#pragma unroll
        for (int ai = 0; ai < 2; ++ai)
#pragma unroll
            for (int m = 0; m < 4; ++m) { const int row = row0 + ai * HALF + m * 16;
                if (row < MROWS) {
#pragma unroll
                    for (int bj = 0; bj < 2; ++bj)
#pragma unroll
                        for (int n = 0; n < 2; ++n) { float* d = PRE + (size_t)row * DM + col0 + bj * HALF + n * 16;
#pragma unroll
                            for (int j = 0; j < 4; ++j) atomicAdd(d + j, acc[ai][bj][m][n][j]); } } }
    }
};
}

__device__ __forceinline__ void phase_convert(const Params& p, lds_t* L) {
    const int tid = opaque_tid(), lane = tid & 63, w = tid >> 6, bid = blockIdx.x, nb = gridDim.x;
    const float* w_in = p.in[8];
    for (int i = tid; i < 1024 * 8; i += NTHR) { const int k = i >> 3, c = i & 7; *(LAS float*)(L + (c * 1024 + k) * 4) = w_in[(size_t)k * INW + 4352 + c]; }
    __syncthreads();
    bf16_t* XB = (bf16_t*)(p.ws + W_XB); float* AB = (float*)(p.ws + W_AB);
    for (int r = bid * 8 + w; r < MPAD; r += nb * 8) {
        if (r >= MROWS) {
#pragma unroll
            for (int i = 0; i < 4; ++i) *(u32x2*)(XB + (size_t)r * DM + 4 * (lane + 64 * i)) = (u32x2){0u, 0u};
            continue;
        }
        const float* xr = r < NPROMPT ? p.in[0] + (size_t)r * DM : p.in[1] + (size_t)(r - NPROMPT) * DM;
        float a8[8];
#pragma unroll
        for (int c = 0; c < 8; ++c) a8[c] = 0.f;
#pragma unroll
        for (int i = 0; i < 4; ++i) {
            const int k4 = lane + 64 * i; const f32x4 xv = *(const f32x4*)(xr + 4 * k4);
            u32x2 o; o[0] = pk2(xv[0], xv[1]); o[1] = pk2(xv[2], xv[3]);
            *(u32x2*)(XB + (size_t)r * DM + 4 * k4) = o;
            if (r >= NPROMPT) *(f32x4*)((float*)(p.ws + W_PRE) + (size_t)r * DM + 4 * k4) = xv * ALPHA;
#pragma unroll
            for (int c = 0; c < 8; ++c) { const f32x4 wv = *(const LAS f32x4*)(L + (c * 1024 + 4 * k4) * 4); a8[c] += xv[0] * wv[0] + xv[1] * wv[1] + xv[2] * wv[2] + xv[3] * wv[3]; }
        }
#pragma unroll
        for (int c = 0; c < 8; ++c) a8[c] = wave_sum(a8[c]);
        if (lane == 0) {
#pragma unroll
            for (int c = 0; c < 8; ++c) AB[(size_t)r * 8 + c] = a8[c];
        }
    }
    {
        bf16_t* OATT = (bf16_t*)(p.ws + W_OATT); bf16_t* ODN = (bf16_t*)(p.ws + W_ODN);
        for (int i = bid * NTHR + tid; i < 128 * 256 / 2; i += nb * NTHR) ((unsigned*)(OATT + (size_t)MROWS * 256))[i] = 0u;
        for (int i = bid * NTHR + tid; i < 128 * 512 / 2; i += nb * NTHR) ((unsigned*)(ODN + (size_t)MROWS * 512))[i] = 0u;
    }
    const int TOFF = 32768;
    for (int tix = bid; tix < 4160; tix += nb) {
        const float* src; bf16_t* dst; int ld, K, kt, ntile, ncoloff = 0;
        if (tix < 1600) { src = p.in[8]; dst = (bf16_t*)(p.ws + W_WIN); ld = INW; K = 1024; kt = tix / 100; ntile = tix % 100; ncoloff = (ntile * 64 >= 4352) ? 8 : 0; }
        else if (tix < 3008) { const int t = tix - 1600; src = p.in[18]; dst = (bf16_t*)(p.ws + W_WUP); ld = NUP; K = 1024; kt = t / 88; ntile = t % 88; }
        else if (tix < 3712) { const int t = tix - 3008; src = p.in[21]; dst = (bf16_t*)(p.ws + W_WDN); ld = 1024; K = DFF; kt = t / 16; ntile = t % 16; }
        else if (tix < 3968) { const int t = tix - 3712; src = p.in[15]; dst = (bf16_t*)(p.ws + W_WO); ld = 1024; K = 1024; kt = t / 16; ntile = t % 16; }
        else if (tix < 4032) { const int t = tix - 3968; src = p.in[13]; dst = (bf16_t*)(p.ws + W_WAO); ld = 1024; K = 256; kt = t / 16; ntile = t % 16; }
        else { const int t = tix - 4032; src = p.in[14]; dst = (bf16_t*)(p.ws + W_WDO); ld = 1024; K = 512; kt = t / 16; ntile = t % 16; }
        __syncthreads();
#pragma unroll
        for (int e = 0; e < 8; ++e) { const int idx = tid + NTHR * e, r = idx >> 6, c = idx & 63;
            *(LAS float*)(L + TOFF + (r * 65 + c) * 4) = src[(size_t)(kt * 64 + r) * ld + ntile * 64 + ncoloff + c]; }
        __syncthreads();
#pragma unroll
        for (int e = 0; e < 8; ++e) { const int idx = tid + NTHR * e, r = idx >> 6, c = idx & 63;
            dst[(size_t)(ntile * 64 + r) * K + kt * 64 + c] = f2bf(*(const LAS float*)(L + TOFF + (c * 65 + r) * 4)); }
    }
}

__device__ __forceinline__ void dn_prep_task(const Params& p, lds_t* L, int task) {
    const int tid = opaque_tid(), lane = tid & 63, w = tid >> 6, fr = lane & 15, lg = lane >> 4;
    const int b = task >> 9, h = (task >> 7) & 3, n = task & 127;
    const bf16_t* PROJ = (const bf16_t*)(p.ws + W_PROJ);
    const float* AB = (const float*)(p.ws + W_AB);
    unsigned char* tb = p.ws + W_DNT + (size_t)task * TASK_BYTES;
    constexpr int RS = 129;
    constexpr int QF = 0, QB = 64 * RS * 4, KB = QB + 64 * 272, KF = KB + 64 * 272, VF = KF + 64 * RS * 4, LM = VF + 64 * RS * 4, SM = LM + 16384, XS = 0;
    __syncthreads();
    const float* wc = p.in[9];
    {
        constexpr int k0 = 0;
        u32x4 xr[6][4];
#pragma unroll
        for (int k = 0; k < 6; ++k) { const int idx = tid + NTHR * (k0 + k), i = idx / 48, ck = idx % 48, part = ck >> 4, d0 = (ck & 15) * 8;
            const int ch = part * 512 + h * 128 + d0, t = n * 64 + i;
#pragma unroll
            for (int j = 0; j < 4; ++j) { const int tt = t - 3 + j; xr[k][j] = (tt >= 0) ? *(const u32x4*)(PROJ + (size_t)(b * T_SEQ + tt) * NPROJ + C_DN + ch) : (u32x4){0u, 0u, 0u, 0u}; } }
#pragma unroll
        for (int k = 0; k < 6; ++k) { const int idx = tid + NTHR * (k0 + k), i = idx / 48, ck = idx % 48, part = ck >> 4, d0 = (ck & 15) * 8;
            const int ch = part * 512 + h * 128 + d0;
            float acc[8];
#pragma unroll
            for (int e = 0; e < 8; ++e) acc[e] = 0.f;
#pragma unroll
            for (int j = 0; j < 4; ++j) { const f32x4 w0 = *(const f32x4*)(wc + j * 1536 + ch), w1 = *(const f32x4*)(wc + j * 1536 + ch + 4);
                const f32x4 x0 = bf4_to_f4((u32x2){xr[k][j].x, xr[k][j].y}), x1 = bf4_to_f4((u32x2){xr[k][j].z, xr[k][j].w});
#pragma unroll
                for (int e = 0; e < 4; ++e) { acc[e] += w0[e] * x0[e]; acc[4 + e] += w1[e] * x1[e]; } }
            const int base = (part == 0 ? QF : (part == 1 ? KF : VF)) + (i * RS + d0) * 4;
#pragma unroll
            for (int e = 0; e < 8; ++e) *(LAS float*)(L + base + e * 4) = siluf_(acc[e]);
        }
    }
    if (w == 0) {
        const size_t row = (size_t)b * T_SEQ + n * 64 + lane;
        const float braw = AB[row * 8 + h], araw = AB[row * 8 + 4 + h];
        const float beta = sigmoidf_(braw);
        float g = -__expf(p.in[10][h]) * softplusf_(araw + p.in[11][h]);
#pragma unroll
        for (int o = 1; o < 64; o <<= 1) { const float t2 = __shfl_up(g, o, 64); if (lane >= o) g += t2; }
        *(LAS float*)(L + SM + lane * 4) = g; *(LAS float*)(L + SM + 256 + lane * 4) = beta; *(LAS float*)(L + SM + 512 + lane * 4) = __expf(g);
    }
    __syncthreads();
    for (int ii = 0; ii < 8; ++ii) {
        const int i = w * 8 + ii;
        { float v0 = *(LAS float*)(L + QF + (i * RS + lane) * 4), v1 = *(LAS float*)(L + QF + (i * RS + lane + 64) * 4);
          const float rn = rsqrtf(wave_sum(v0 * v0 + v1 * v1) + 1e-6f) * 0.08838834764831845f; v0 *= rn; v1 *= rn;
          *(LAS float*)(L + QF + (i * RS + lane) * 4) = v0; *(LAS float*)(L + QF + (i * RS + lane + 64) * 4) = v1;
          *(LAS bf16_t*)(L + QB + i * 272 + lane * 2) = f2bf(v0); *(LAS bf16_t*)(L + QB + i * 272 + (lane + 64) * 2) = f2bf(v1); }
        { float v0 = *(LAS float*)(L + KF + (i * RS + lane) * 4), v1 = *(LAS float*)(L + KF + (i * RS + lane + 64) * 4);
          const float rn = rsqrtf(wave_sum(v0 * v0 + v1 * v1) + 1e-6f); v0 *= rn; v1 *= rn;
          *(LAS float*)(L + KF + (i * RS + lane) * 4) = v0; *(LAS float*)(L + KF + (i * RS + lane + 64) * 4) = v1;
          *(LAS bf16_t*)(L + KB + i * 272 + lane * 2) = f2bf(v0); *(LAS bf16_t*)(L + KB + i * 272 + (lane + 64) * 2) = f2bf(v1); }
    }
    __syncthreads();
    for (int jj = 0; jj < 4; ++jj) {
        const int job = w * 4 + jj, which = job >> 4, mi = (job >> 2) & 3, nj = job & 3;
        if (which == 0 && nj > mi) continue;
        f32x4 acc = (f32x4){0.f, 0.f, 0.f, 0.f};
        if (nj <= mi) {
#pragma unroll
            for (int ks = 0; ks < 4; ++ks) {
                const bf16x8 a = *(const LAS bf16x8*)(L + (which ? QB : KB) + (mi * 16 + fr) * 272 + (ks * 32 + lg * 8) * 2);
                const bf16x8 bb = *(const LAS bf16x8*)(L + KB + (nj * 16 + fr) * 272 + (ks * 32 + lg * 8) * 2);
                acc = mfma16(a, bb, acc);
            }
        }
        const int j = nj * 16 + fr; const float gj = *(LAS float*)(L + SM + j * 4);
#pragma unroll
        for (int r = 0; r < 4; ++r) {
            const int i = mi * 16 + lg * 4 + r; const float gi = *(LAS float*)(L + SM + i * 4);
            if (which == 0) { const float v = (j < i) ? *(LAS float*)(L + SM + 256 + i * 4) * acc[r] * __expf(gi - gj) : 0.f; *(LAS float*)(L + LM + (i * 64 + j) * 4) = v; }
            else { const float v = (j <= i) ? acc[r] * __expf(gi - gj) : 0.f; *(bf16_t*)(tb + 81920 + (i * 64 + j) * 2) = f2bf(v); }
        }
    }
    __syncthreads();
    {
        const float glast = *(LAS float*)(L + SM + 63 * 4);
        for (int idx = tid; idx < 8192; idx += NTHR) { const int i = idx >> 7, d = idx & 127;
            *(bf16_t*)(tb + 49152 + idx * 2) = f2bf(*(LAS float*)(L + QF + (i * RS + d) * 4) * *(LAS float*)(L + SM + 512 + i * 4)); }
        for (int idx = tid; idx < 8192; idx += NTHR) { const int d = idx >> 6, i = idx & 63;
            *(bf16_t*)(tb + 65536 + idx * 2) = f2bf(*(LAS float*)(L + KF + (i * RS + d) * 4) * __expf(glast - *(LAS float*)(L + SM + i * 4))); }
        if (tid == 0) { ((float*)(p.ws + W_GL))[task] = __expf(glast); *(float*)(tb + 90112) = __expf(glast); }
    }
    __syncthreads();
    if (tid < 256) {
        const int c = tid;
        for (int blk = 0; blk < 4; ++blk) {
            float r[16];
#pragma unroll
            for (int ii = 0; ii < 16; ++ii) { const int i = blk * 16 + ii; const float beta = *(LAS float*)(L + SM + 256 + i * 4);
                r[ii] = (c < 128) ? beta * *(LAS float*)(L + VF + (i * RS + c) * 4) : beta * *(LAS float*)(L + KF + (i * RS + (c - 128)) * 4) * *(LAS float*)(L + SM + 512 + i * 4); }
            for (int pb = 0; pb < blk; ++pb) {
                float xp[16];
#pragma unroll
                for (int jj = 0; jj < 16; ++jj) xp[jj] = *(LAS float*)(L + XS + ((pb * 16 + jj) * 256 + c) * 4);
#pragma unroll
                for (int ii = 0; ii < 16; ++ii) {
#pragma unroll
                    for (int j4 = 0; j4 < 4; ++j4) { const f32x4 l4 = *(const LAS f32x4*)(L + LM + ((blk * 16 + ii) * 64 + pb * 16 + j4 * 4) * 4);
                        r[ii] -= l4[0] * xp[j4 * 4] + l4[1] * xp[j4 * 4 + 1] + l4[2] * xp[j4 * 4 + 2] + l4[3] * xp[j4 * 4 + 3]; }
                }
            }
#pragma unroll
            for (int ii = 1; ii < 16; ++ii) {
#pragma unroll
                for (int jj = 0; jj < ii; ++jj) r[ii] -= *(LAS float*)(L + LM + ((blk * 16 + ii) * 64 + blk * 16 + jj) * 4) * r[jj];
            }
#pragma unroll
            for (int ii = 0; ii < 16; ++ii) *(LAS float*)(L + XS + ((blk * 16 + ii) * 256 + c) * 4) = r[ii];
            if (c < 128) {
                const int wv = c >> 4;
#pragma unroll
                for (int ii = 0; ii < 16; ++ii) { const int gq = ii >> 2, jr = ii & 3, l = gq * 16 + (c & 15);
                    *(float*)(tb + (size_t)(((wv * 4 + blk) * 64 + l) * 4 + jr) * 4) = r[ii]; }
            } else {
#pragma unroll
                for (int ii = 0; ii < 16; ++ii) *(bf16_t*)(tb + 32768 + ((blk * 16 + ii) * 128 + (c - 128)) * 2) = f2bf(r[ii]);
            }
        }
    }
}

#define SBAR() do { asm volatile("s_waitcnt lgkmcnt(0)" ::: "memory"); __builtin_amdgcn_s_barrier(); asm volatile("" ::: "memory"); } while (0)
__device__ __forceinline__ void dn_scan(const Params& p, lds_t* L, int sb) {
    const int tid = opaque_tid(), lane = tid & 63, w = __builtin_amdgcn_readfirstlane(tid >> 6);
    const int bh = sb >> 3, sl = sb & 7;
    constexpr int BUFSZ = 67584, WKO = 0, QDO = 16384, KDO = 32768, ATO = 49152, U0O = 57344, GLO = 65536, PRIV = 2 * BUFSZ;
    const unsigned char* tb0 = p.ws + W_DNT + (size_t)(bh * 128) * TASK_BYTES;
    if (w >= 2) {
        const int t = tid - 128;
        int soff[11], ldst[11];
#pragma unroll
        for (int i = 0; i < 11; ++i) { int cid = t + 384 * i; if (cid >= 3840) cid = t;
            if (cid < 2048) { const int row = (cid & 1023) >> 4, ch = cid & 15; ldst[i] = (cid >> 10) * 16384 + row * 256 + ((ch ^ (row & 15)) << 4); soff[i] = 32768 + cid * 16; }
            else if (cid < 3584) { const int cl = cid - 2048, row = cl >> 3, ch = cl & 7; ldst[i] = 32768 + row * 128 + ((ch ^ (row & 7)) << 4); soff[i] = 32768 + cid * 16; }
            else { ldst[i] = U0O + (cid - 3584) * 16; soff[i] = sl * 4096 + (cid - 3584) * 16; } }
        if (t == 383) { ldst[10] = GLO; soff[10] = 90112; }
        u32x4 R0[11], R1[11], R2[11];
#define SC_LOAD(R, step) do { const unsigned char* _g = tb0 + (size_t)(step) * TASK_BYTES; \
        _Pragma("unroll") for (int i = 0; i < 11; ++i) R[i] = *(const u32x4*)(_g + soff[i]); } while (0)
#define SC_PUT(R, step) do { lds_t* _d = L + ((step) & 1) * BUFSZ; \
        _Pragma("unroll") for (int i = 0; i < 11; ++i) *(LAS u32x4*)(_d + ldst[i]) = R[i]; } while (0)
        SC_LOAD(R0, 0); SC_LOAD(R1, 1); SC_LOAD(R2, 2);
        SC_PUT(R0, 0); SC_LOAD(R0, 3);
        for (int n0 = 0; n0 < 123; n0 += 3) {
            SBAR(); SC_PUT(R1, n0 + 1); SC_LOAD(R1, n0 + 4); SBAR();
            SBAR(); SC_PUT(R2, n0 + 2); SC_LOAD(R2, n0 + 5); SBAR();
            SBAR(); SC_PUT(R0, n0 + 3); SC_LOAD(R0, n0 + 6); SBAR();
        }
        SBAR(); SC_PUT(R1, 124); SC_LOAD(R1, 127); SBAR();
        SBAR(); SC_PUT(R2, 125); SBAR();
        SBAR(); SC_PUT(R0, 126); SBAR();
        SBAR(); SC_PUT(R1, 127); SBAR();
        SBAR(); SBAR();
#undef SC_LOAD
#undef SC_PUT
    } else {
        const int fr = lane & 15, lg = lane >> 4;
        lds_t* ST = L + PRIV; lds_t* UT = ST + 4096;
        f32x4 S[4];
#pragma unroll
        for (int m = 0; m < 4; ++m) S[m] = (f32x4){0.f, 0.f, 0.f, 0.f};
        for (int n = 0; n < 128; ++n) {
#pragma unroll
            for (int m = 0; m < 4; ++m) { const int mm = 4 * w + m; u32x2 v; v[0] = pk2(S[m][0], S[m][1]); v[1] = pk2(S[m][2], S[m][3]);
                *(LAS u32x2*)(ST + fr * 256 + (((mm * 2 + (lg >> 1)) ^ fr) << 4) + (lg & 1) * 8) = v; }
            SBAR();
            bf16x8 sb4[4];
#pragma unroll
            for (int ks = 0; ks < 4; ++ks) sb4[ks] = *(const LAS bf16x8*)(ST + fr * 256 + (((ks * 4 + lg) ^ fr) << 4));
            lds_t* B = L + (n & 1) * BUFSZ;
            const float glc = *(const LAS float*)(B + GLO);
            f32x4 au[2], ao[2];
#pragma unroll
            for (int q = 0; q < 2; ++q) { const int mt = 2 * w + q; au[q] = (f32x4){0.f, 0.f, 0.f, 0.f}; ao[q] = (f32x4){0.f, 0.f, 0.f, 0.f};
#pragma unroll
                for (int ks = 0; ks < 4; ++ks) {
                    const int rofs = (mt * 16 + fr) * 256 + (((ks * 4 + lg) ^ fr) << 4);
                    const bf16x8 a1 = *(const LAS bf16x8*)(B + WKO + rofs); const bf16x8 a2 = *(const LAS bf16x8*)(B + QDO + rofs);
                    au[q] = mfma16(a1, sb4[ks], au[q]); ao[q] = mfma16(a2, sb4[ks], ao[q]);
                }
            }
#pragma unroll
            for (int q = 0; q < 2; ++q) { const int mt = 2 * w + q; const f32x4 u0 = *(const LAS f32x4*)(B + U0O + (mt * 64 + lane) * 16);
                f32x4 u = u0 - au[q]; u32x2 v; v[0] = pk2(u[0], u[1]); v[1] = pk2(u[2], u[3]);
                *(LAS u32x2*)(UT + fr * 128 + (((mt * 2 + (lg >> 1)) ^ (fr & 7)) << 4) + (lg & 1) * 8) = v; }
            SBAR();
            bf16x8 ub[2];
#pragma unroll
            for (int ks = 0; ks < 2; ++ks) ub[ks] = *(const LAS bf16x8*)(UT + fr * 128 + (((ks * 4 + lg) ^ (fr & 7)) << 4));
#pragma unroll
            for (int q = 0; q < 2; ++q) { const int mt = 2 * w + q;
#pragma unroll
                for (int ks = 0; ks < 2; ++ks) { const bf16x8 a = *(const LAS bf16x8*)(B + ATO + (mt * 16 + fr) * 128 + (((ks * 4 + lg) ^ (fr & 7)) << 4)); ao[q] = mfma16(a, ub[ks], ao[q]); } }
#pragma unroll
            for (int m = 0; m < 4; ++m) { const int mm = 4 * w + m; S[m] = S[m] * glc;
#pragma unroll
                for (int ks = 0; ks < 2; ++ks) { const bf16x8 a = *(const LAS bf16x8*)(B + KDO + (mm * 16 + fr) * 128 + (((ks * 4 + lg) ^ (fr & 7)) << 4)); S[m] = mfma16(a, ub[ks], S[m]); } }
            float* osc = (float*)(p.ws + W_OSC + (size_t)(bh * 128 + n) * 32768);
#pragma unroll
            for (int q = 0; q < 2; ++q) *(f32x4*)(osc + ((sl * 4 + 2 * w + q) * 64 + lane) * 4) = ao[q];
        }
        float* ps = p.out + O_PDS + (size_t)bh * 16384;
#pragma unroll
        for (int m = 0; m < 4; ++m)
#pragma unroll
            for (int r = 0; r < 4; ++r) ps[((4 * w + m) * 16 + lg * 4 + r) * 128 + sl * 16 + fr] = S[m][r];
    }
    __syncthreads();
}

__device__ __forceinline__ void dn_norm_item(const Params& p, int item) {
    const int pm = item >> 2, h = item & 3;
    const int tid = opaque_tid(), lane = tid & 63, w = tid >> 6;
    const bf16_t* PROJ = (const bf16_t*)(p.ws + W_PROJ);
    bf16_t* ODN = (bf16_t*)(p.ws + W_ODN);
    const int e0 = 2 * lane, sl = e0 >> 4, fr = e0 & 15;
    const float wn0 = p.in[12][e0], wn1 = p.in[12][e0 + 1];
    for (int it0 = 0; it0 < 8; it0 += 4) {
        f32x4 va[4], vb[4]; unsigned zz[4][4];
#pragma unroll
        for (int u = 0; u < 4; ++u) {
            const int rq = (it0 + u) * 8 + w;
            const int row0 = pm * 256 + rq * 4, b = row0 >> 13, t = row0 & (T_SEQ - 1), n = t >> 6, i0 = t & 63;
            const float* src = (const float*)(p.ws + W_OSC + (size_t)((b * 4 + h) * 128 + n) * 32768) + ((sl * 4 + (i0 >> 4)) * 64 + ((i0 & 15) >> 2) * 16 + fr) * 4;
            va[u] = *(const f32x4*)src; vb[u] = *(const f32x4*)(src + 4);
#pragma unroll
            for (int r = 0; r < 4; ++r) zz[u][r] = *(const unsigned*)(PROJ + (size_t)(row0 + r) * NPROJ + C_Z + h * 128 + e0);
        }
#pragma unroll
        for (int u = 0; u < 4; ++u) {
            const int rq = (it0 + u) * 8 + w;
            const int row0 = pm * 256 + rq * 4;
#pragma unroll
            for (int r = 0; r < 4; ++r) {
                const float ss = wave_sum(va[u][r] * va[u][r] + vb[u][r] * vb[u][r]); const float rs = rsqrtf(ss * (1.0f / 128.0f) + 1e-6f);
                const float z0 = __uint_as_float(zz[u][r] << 16), z1 = __uint_as_float(zz[u][r] & 0xFFFF0000u);
                *(unsigned*)(ODN + (size_t)(row0 + r) * 512 + h * 128 + e0) = pk2(va[u][r] * rs * wn0 * siluf_(z0), vb[u][r] * rs * wn1 * siluf_(z1));
            }
        }
    }
}

__device__ __forceinline__ void attn_prompt_item(const Params& p, lds_t* L, int item) {
    const int tid = opaque_tid(), lane = tid & 63, w = tid >> 6, fr = lane & 15, lg = lane >> 4;
    const int b = item >> 7, blk = (item >> 2) & 31, h = item & 3;
    const bf16_t* PROJ = (const bf16_t*)(p.ws + W_PROJ);
    float* OG = (float*)(p.ws + W_OG); float* LSE = (float*)(p.ws + W_LSE);
    lds_t* VS = L + w * 4352;
    const int T0 = blk * 256;
    for (int wt = w; wt < 48; wt += 8) {
        const int grp = wt >> 4, qt = wt & 15;
        const int dl = grp == 0 ? 0 : (grp == 1 ? 2 : 4), dil = 1 << dl;
        const int tpr = 16 >> dl;
        const int res = qt / tpr, qq = qt % tpr;
        const int j0 = (T0 >> dl) + qq * 16;
        const float slope_d = exp2f(-8.0f * (float)(grp * 4 + h + 1) / 12.0f) * (float)dil;
        const size_t rowbase = (size_t)b * T_SEQ;
        const int tq = ((j0 + fr) << dl) + res;
        bf16x8 qb[2];
#pragma unroll
        for (int ks = 0; ks < 2; ++ks) qb[ks] = *(const bf16x8*)(PROJ + (rowbase + tq) * NPROJ + grp * 256 + h * 64 + ks * 32 + lg * 8);
        f32x4 o[4];
#pragma unroll
        for (int dt = 0; dt < 4; ++dt) o[dt] = (f32x4){0.f, 0.f, 0.f, 0.f};
        float mrun = -1e30f, lrun = 0.f;
        const int jq = j0 + fr;
        u32x4 vreg[2][4]; bf16x8 kreg[2][2][2];
#define AT_LOAD(kt, bufi) do { const int _jb = j0 - 144 + (kt) * 32; \
            _Pragma("unroll") for (int i = 0; i < 4; ++i) { const int c = lane + 64 * i, key = c >> 3, part = c & 7; int jk = _jb + key; jk = jk < 0 ? 0 : jk; \
                vreg[bufi][i] = *(const u32x4*)(PROJ + (rowbase + (jk << dl) + res) * NPROJ + C_AV + grp * 256 + h * 64 + part * 8); } \
            _Pragma("unroll") for (int kh = 0; kh < 2; ++kh) { int jk = _jb + kh * 16 + fr; jk = jk < 0 ? 0 : jk; \
                const bf16_t* kp = PROJ + (rowbase + (jk << dl) + res) * NPROJ + C_AK + grp * 256 + h * 64 + lg * 8; \
                kreg[bufi][kh][0] = *(const bf16x8*)kp; kreg[bufi][kh][1] = *(const bf16x8*)(kp + 32); } } while (0)
        AT_LOAD(0, 0);
#pragma unroll
        for (int kt = 0; kt < 5; ++kt) {
            const int jb = j0 - 144 + kt * 32, cur = kt & 1;
            if (kt + 1 < 5) AT_LOAD(kt + 1, cur ^ 1);
#pragma unroll
            for (int i = 0; i < 4; ++i) { const int c = lane + 64 * i, key = c >> 3, part = c & 7; const u32x4 v = vreg[cur][i];
                *(LAS u32x2*)(VS + key * 136 + part * 16) = (u32x2){v.x, v.y}; *(LAS u32x2*)(VS + key * 136 + part * 16 + 8) = (u32x2){v.z, v.w}; }
            f32x4 sc[2];
#pragma unroll
            for (int kh = 0; kh < 2; ++kh) { sc[kh] = (f32x4){0.f, 0.f, 0.f, 0.f};
#pragma unroll
                for (int ks = 0; ks < 2; ++ks) sc[kh] = mfma16(kreg[cur][kh][ks], qb[ks], sc[kh]); }
            float mx = -1e30f;
#pragma unroll
            for (int kh = 0; kh < 2; ++kh)
#pragma unroll
                for (int r = 0; r < 4; ++r) { const int jk = jb + kh * 16 + lg * 4 + r; const int dist = jq - jk;
                    const bool ok = (jk >= 0) && (dist >= 0) && (dist <= 128);
                    const float s = ok ? sc[kh][r] * 0.125f - slope_d * (float)dist : -1e30f; sc[kh][r] = s; mx = fmaxf(mx, s); }
            mx = fmaxf(mx, __shfl_xor(mx, 16, 64)); mx = fmaxf(mx, __shfl_xor(mx, 32, 64));
            const float mnew = fmaxf(mrun, mx); const float scale = __expf(mrun - mnew); mrun = mnew;
            float ps = 0.f; float pv[8];
#pragma unroll
            for (int kh = 0; kh < 2; ++kh)
#pragma unroll
                for (int r = 0; r < 4; ++r) { const float s = sc[kh][r]; const float pe = s > -1e29f ? __expf(s - mnew) : 0.f; pv[kh * 4 + r] = pe; ps += pe; }
            lrun = lrun * scale + ps;
            bf16x8 pb; { unsigned* pw = (unsigned*)&pb; pw[0] = pk2(pv[0], pv[1]); pw[1] = pk2(pv[2], pv[3]); pw[2] = pk2(pv[4], pv[5]); pw[3] = pk2(pv[6], pv[7]); }
            WSYNC();
#pragma unroll
            for (int dt = 0; dt < 4; ++dt) {
                bf16x8 va; unsigned short* vs = (unsigned short*)&va;
#pragma unroll
                for (int i = 0; i < 8; ++i) { const int key = (i < 4) ? (lg * 4 + i) : (16 + lg * 4 + (i - 4)); vs[i] = *(const LAS bf16_t*)(VS + key * 136 + (dt * 16 + fr) * 2); }
                o[dt] = o[dt] * scale; o[dt] = mfma16(va, pb, o[dt]);
            }
            WSYNC();
        }
#undef AT_LOAD
        lrun += __shfl_xor(lrun, 16, 64); lrun += __shfl_xor(lrun, 32, 64);
        const float inv = 1.0f / lrun;
        const size_t orow = rowbase + tq;
#pragma unroll
        for (int dt = 0; dt < 4; ++dt) { f32x4 v = o[dt] * inv; *(f32x4*)(OG + ((size_t)grp * NPROMPT + orow) * 256 + h * 64 + dt * 16 + lg * 4) = v; }
        if (lg == 0) LSE[((size_t)grp * NPROMPT + orow) * 4 + h] = mrun + __logf(lrun);
    }
    asm volatile("s_waitcnt vmcnt(0)" ::: "memory");
    __syncthreads();
    {
        bf16_t* OATT = (bf16_t*)(p.ws + W_OATT);
        const int i = tid >> 1, half = tid & 1; const size_t row = (size_t)b * T_SEQ + T0 + i;
        const float l0 = LSE[(0 * (size_t)NPROMPT + row) * 4 + h], l1 = LSE[(1 * (size_t)NPROMPT + row) * 4 + h], l2 = LSE[(2 * (size_t)NPROMPT + row) * 4 + h];
        const float mx = fmaxf(l0, fmaxf(l1, l2)); float w0 = __expf(l0 - mx), w1 = __expf(l1 - mx), w2 = __expf(l2 - mx); const float inv = 1.0f / (w0 + w1 + w2); w0 *= inv; w1 *= inv; w2 *= inv;
#pragma unroll
        for (int c4 = 0; c4 < 8; ++c4) { const int col = h * 64 + half * 32 + c4 * 4;
            const f32x4 a0 = *(const f32x4*)(OG + (0 * (size_t)NPROMPT + row) * 256 + col), a1 = *(const f32x4*)(OG + (1 * (size_t)NPROMPT + row) * 256 + col), a2 = *(const f32x4*)(OG + (2 * (size_t)NPROMPT + row) * 256 + col);
            const f32x4 r = a0 * w0 + a1 * w1 + a2 * w2; u32x2 v; v[0] = pk2(r[0], r[1]); v[1] = pk2(r[2], r[3]);
            *(u32x2*)(OATT + row * 256 + col) = v; }
    }
}

__device__ __forceinline__ void attn_decode_item(const Params& p, lds_t* L, int b) {
    const int tid = opaque_tid(), lane = tid & 63, w = tid >> 6, sub = lane & 15, kq = lane >> 4;
    const bf16_t* PROJ = (const bf16_t*)(p.ws + W_PROJ);
    const size_t prow = (size_t)(NPROMPT + b) * NPROJ;
#pragma unroll 1
    for (int idx = w; idx < 12; idx += 8) {
        const int grp = idx >> 2, h = idx & 3;
        const int dl = grp == 0 ? 0 : (grp == 1 ? 2 : 4), dil = 1 << dl, n = 128 << dl;
        const float* cache = (grp == 0 ? p.in[2] : (grp == 1 ? p.in[3] : p.in[4])) + (size_t)b * n * 512;
        const float slope_d = exp2f(-8.0f * (float)(grp * 4 + h + 1) / 12.0f) * (float)dil;
        f32x4 q4 = bf4_to_f4(*(const u32x2*)(PROJ + prow + grp * 256 + h * 64 + sub * 4));
        lds_t* SC = L + w * 544;
#pragma unroll 1
        for (int it0 = 0; it0 < 32; it0 += 8) {
            f32x4 k4[8];
#pragma unroll
            for (int u = 0; u < 8; ++u) k4[u] = *(const f32x4*)(cache + (size_t)(((it0 + u) * 4 + kq) * dil) * 512 + h * 64 + sub * 4);
#pragma unroll
            for (int u = 0; u < 8; ++u) { const int c = (it0 + u) * 4 + kq;
                const float part = sum16(q4[0] * k4[u][0] + q4[1] * k4[u][1] + q4[2] * k4[u][2] + q4[3] * k4[u][3]);
                if (sub == 0) *(LAS float*)(SC + c * 4) = part * 0.125f - slope_d * (float)(128 - c); }
        }
        {
            const f32x4 kn = bf4_to_f4(*(const u32x2*)(PROJ + prow + C_AK + grp * 256 + h * 64 + sub * 4));
            const float part = sum16(q4[0] * kn[0] + q4[1] * kn[1] + q4[2] * kn[2] + q4[3] * kn[3]);
            if (sub == 0) *(LAS float*)(SC + (128 + kq) * 4) = (kq == 0) ? part * 0.125f : -1e30f;
        }
        WSYNC();
        const float s0 = *(LAS float*)(SC + lane * 4), s1 = *(LAS float*)(SC + (lane + 64) * 4), s2 = lane < 4 ? *(LAS float*)(SC + (lane + 128) * 4) : -1e30f;
        const float m = wave_max(fmaxf(s0, fmaxf(s1, s2)));
        const float p0 = __expf(s0 - m), p1 = __expf(s1 - m), p2 = lane < 4 ? __expf(s2 - m) : 0.f;
        const float lsum = wave_sum(p0 + p1 + p2);
        WSYNC();
        *(LAS float*)(SC + lane * 4) = p0; *(LAS float*)(SC + (lane + 64) * 4) = p1; if (lane < 4) *(LAS float*)(SC + (lane + 128) * 4) = p2;
        WSYNC();
        f32x4 acc = (f32x4){0.f, 0.f, 0.f, 0.f};
#pragma unroll 1
        for (int it0 = 0; it0 < 32; it0 += 8) {
            f32x4 v4[8];
#pragma unroll
            for (int u = 0; u < 8; ++u) v4[u] = *(const f32x4*)(cache + (size_t)(((it0 + u) * 4 + kq) * dil) * 512 + 256 + h * 64 + sub * 4);
#pragma unroll
            for (int u = 0; u < 8; ++u) { const float pc = *(LAS float*)(SC + ((it0 + u) * 4 + kq) * 4); acc += v4[u] * pc; }
        }
        if (kq == 0) { const float pc = *(LAS float*)(SC + 128 * 4); acc += bf4_to_f4(*(const u32x2*)(PROJ + prow + C_AV + grp * 256 + h * 64 + sub * 4)) * pc; }
#pragma unroll
        for (int j = 0; j < 4; ++j) { acc[j] += __shfl_xor(acc[j], 16, 64); acc[j] += __shfl_xor(acc[j], 32, 64); }
        const float inv = 1.0f / lsum;
        if (kq == 0) {
#pragma unroll
            for (int j = 0; j < 4; ++j) *(LAS float*)(L + 8192 + (idx * 65 + sub * 4 + j) * 4) = acc[j] * inv;
        }
        if (lane == 0) *(LAS float*)(L + 8192 + 3120 + idx * 4) = m + __logf(lsum);
        WSYNC();
    }
    __syncthreads();
    if (tid < 256) {
        const int h = tid >> 6, d = tid & 63;
        const float l0 = *(LAS float*)(L + 8192 + 3120 + h * 4), l1 = *(LAS float*)(L + 8192 + 3120 + (4 + h) * 4), l2 = *(LAS float*)(L + 8192 + 3120 + (8 + h) * 4);
        const float mx = fmaxf(l0, fmaxf(l1, l2)); const float w0 = __expf(l0 - mx), w1 = __expf(l1 - mx), w2 = __expf(l2 - mx);
        const float r = (w0 * *(LAS float*)(L + 8192 + (h * 65 + d) * 4) + w1 * *(LAS float*)(L + 8192 + ((4 + h) * 65 + d) * 4) + w2 * *(LAS float*)(L + 8192 + ((8 + h) * 65 + d) * 4)) / (w0 + w1 + w2);
        ((bf16_t*)(p.ws + W_OATT))[(size_t)(NPROMPT + b) * 256 + h * 64 + d] = f2bf(r);
    }
}

__device__ __forceinline__ void dn_rec_item(const Params& p, lds_t* L, int item) {
    const int tid = opaque_tid(), b = item >> 2, h = item & 3;
    const bf16_t* PROJ = (const bf16_t*)(p.ws + W_PROJ);
    const float* AB = (const float*)(p.ws + W_AB);
    const size_t prow = (size_t)(NPROMPT + b) * NPROJ;
    const float* cst = p.in[5] + (size_t)b * 3 * 1536;
    if (tid < 384) {
        const int part = tid >> 7, d = tid & 127, ch = part * 512 + h * 128 + d;
        const float* wc = p.in[9];
        const float xn = bf2f(PROJ[prow + C_DN + ch]);
        const float x0 = cst[ch], x1 = cst[1536 + ch], x2 = cst[3072 + ch];
        const float v = wc[ch] * x0 + wc[1536 + ch] * x1 + wc[3072 + ch] * x2 + wc[4608 + ch] * xn;
        *(LAS float*)(L + tid * 4) = siluf_(v);
        float* sdc = p.out + O_SDC + (size_t)b * 3 * 1536;
        sdc[ch] = x1; sdc[1536 + ch] = x2; sdc[3072 + ch] = xn;
    }
    __syncthreads();
    {
        const int w = tid >> 6, lane = tid & 63;
        if (w < 3) {
            const float q0 = *(LAS float*)(L + lane * 4), q1 = *(LAS float*)(L + (lane + 64) * 4), k0 = *(LAS float*)(L + (128 + lane) * 4), k1 = *(LAS float*)(L + (192 + lane) * 4);
            float v = w == 0 ? q0 * q0 + q1 * q1 : (w == 1 ? k0 * k0 + k1 * k1 : q0 * k0 + q1 * k1);
            v = wave_sum(v); if (lane == 0) *(LAS float*)(L + 1536 + w * 4) = v;
        }
    }
    __syncthreads();
    const float rq = rsqrtf(*(LAS float*)(L + 1536) + 1e-6f) * 0.08838834764831845f, rk = rsqrtf(*(LAS float*)(L + 1540) + 1e-6f);
    const float qk = *(LAS float*)(L + 1544) * rq * rk;
    const float beta = sigmoidf_(AB[(size_t)(NPROMPT + b) * 8 + h]);
    const float eg = __expf(-__expf(p.in[10][h]) * softplusf_(AB[(size_t)(NPROMPT + b) * 8 + 4 + h] + p.in[11][h]));
    const float* S0 = p.in[6] + (size_t)item * 16384;
    const int e4 = (tid & 31) * 4, dg = tid >> 5;
    f32x4 s[8]; f32x4 ks = (f32x4){0.f, 0.f, 0.f, 0.f}, qs = (f32x4){0.f, 0.f, 0.f, 0.f};
#pragma unroll
    for (int r = 0; r < 8; ++r) { const int d = dg * 8 + r; s[r] = *(const f32x4*)(S0 + d * 128 + e4);
        const float kd = *(LAS float*)(L + (128 + d) * 4) * rk, qd = *(LAS float*)(L + d * 4) * rq; ks += s[r] * kd; qs += s[r] * qd; }
    *(LAS f32x4*)(L + 2048 + (dg * 128 + e4) * 4) = ks; *(LAS f32x4*)(L + 10240 + (dg * 128 + e4) * 4) = qs;
    __syncthreads();
    if (tid < 128) {
        float kS = 0.f, qS = 0.f;
#pragma unroll
        for (int g = 0; g < 16; ++g) { kS += *(LAS float*)(L + 2048 + (g * 128 + tid) * 4); qS += *(LAS float*)(L + 10240 + (g * 128 + tid) * 4); }
        const float v = *(LAS float*)(L + (256 + tid) * 4);
        const float u = beta * (v - eg * kS);
        const float o = eg * qS + qk * u;
        *(LAS float*)(L + 18432 + tid * 4) = u; *(LAS float*)(L + 18944 + tid * 4) = o;
    }
    __syncthreads();
    {
        const f32x4 u4 = *(const LAS f32x4*)(L + 18432 + e4 * 4);
        float* So = p.out + O_SDS + (size_t)item * 16384;
#pragma unroll
        for (int r = 0; r < 8; ++r) { const int d = dg * 8 + r; const float kd = *(LAS float*)(L + (128 + d) * 4) * rk; *(f32x4*)(So + d * 128 + e4) = s[r] * eg + u4 * kd; }
    }
    if (tid < 64) {
        const float o0 = *(LAS float*)(L + 18944 + tid * 4), o1 = *(LAS float*)(L + 18944 + (tid + 64) * 4);
        const float ms = wave_sum(o0 * o0 + o1 * o1) * (1.0f / 128.0f); const float rs = rsqrtf(ms + 1e-6f);
        bf16_t* ODN = (bf16_t*)(p.ws + W_ODN);
        const float z0 = bf2f(PROJ[prow + C_Z + h * 128 + tid]), z1 = bf2f(PROJ[prow + C_Z + h * 128 + tid + 64]);
        ODN[(size_t)(NPROMPT + b) * 512 + h * 128 + tid] = f2bf(o0 * rs * p.in[12][tid] * siluf_(z0));
        ODN[(size_t)(NPROMPT + b) * 512 + h * 128 + tid + 64] = f2bf(o1 * rs * p.in[12][tid + 64] * siluf_(z1));
    }
}

constexpr int NCHUNK = 2688;
__device__ __forceinline__ void kv_copy_chunk(const Params& p, int cidx) {
    const int tid = opaque_tid();
    int grp, cl;
    if (cidx < 128) { grp = 0; cl = cidx; } else if (cidx < 640) { grp = 1; cl = cidx - 128; } else { grp = 2; cl = cidx - 640; }
    const int dl = grp * 2;
    const f32x4* src = (const f32x4*)(grp == 0 ? p.in[2] : (grp == 1 ? p.in[3] : p.in[4])) + (size_t)cl * 16384;
    f32x4* dst = (f32x4*)(p.out + (grp == 0 ? O_SKV0 : (grp == 1 ? O_SKV1 : O_SKV2))) + (size_t)cl * 16384;
    const int pmask = (1 << (14 + dl)) - 1, q0 = (cl * 16384) & pmask;
    f32x4 va[8], vb[8];
#define CP_LOAD(v, k) do { _Pragma("unroll") for (int u = 0; u < 8; ++u) { const int o = ((k) * 8 + u) * NTHR + tid; \
        const bool ok = ((q0 + o) & pmask) < pmask + 1 - 128; v[u] = __builtin_nontemporal_load(src + o + (ok ? 128 : 0)); } } while (0)
#define CP_STORE(v, k) do { _Pragma("unroll") for (int u = 0; u < 8; ++u) { const int o = ((k) * 8 + u) * NTHR + tid; \
        if (((q0 + o) & pmask) < pmask + 1 - 128) __builtin_nontemporal_store(v[u], dst + o); } } while (0)
    CP_LOAD(va, 0); CP_LOAD(vb, 1); CP_STORE(va, 0); CP_LOAD(va, 2); CP_STORE(vb, 1); CP_LOAD(vb, 3); CP_STORE(va, 2); CP_STORE(vb, 3);
#undef CP_LOAD
#undef CP_STORE
}
__device__ __forceinline__ void kv_lastrow_item(const Params& p, int part) {
    const bf16_t* PROJ = (const bf16_t*)(p.ws + W_PROJ);
    const int tid = opaque_tid();
    u32x2 v[4];
#pragma unroll
    for (int u = 0; u < 4; ++u) { const int i = part * 2048 + u * NTHR + tid;
        const int grp = i >> 14, b = (i >> 7) & 127, e = i & 127, s = e >> 6, rem = (e & 63) * 4;
        v[u] = *(const u32x2*)(PROJ + (size_t)(NPROMPT + b) * NPROJ + C_AK + s * 768 + grp * 256 + rem); }
#pragma unroll
    for (int u = 0; u < 4; ++u) { const int i = part * 2048 + u * NTHR + tid;
        const int grp = i >> 14, b = (i >> 7) & 127, e = i & 127, n = 128 << (grp * 2);
        f32x4* dst = (f32x4*)(p.out + (grp == 0 ? O_SKV0 : (grp == 1 ? O_SKV1 : O_SKV2)));
        dst[((size_t)b * n + (n - 1)) * 128 + e] = bf4_to_f4(v[u]); }
}
__device__ __forceinline__ void pkv_chunk(const Params& p, int cidx) {
    const int tid = opaque_tid();
    const bf16_t* PROJ = (const bf16_t*)(p.ws + W_PROJ);
    for (int i0 = 0; i0 < 32; i0 += 8) {
        u32x2 v[8];
#pragma unroll
        for (int u = 0; u < 8; ++u) { const int q = cidx * 16384 + (i0 + u) * NTHR + tid;
            int grp, ql; if (q < 32768) { grp = 0; ql = q; } else if (q < 163840) { grp = 1; ql = q - 32768; } else { grp = 2; ql = q - 163840; }
            const int keep = 128 << (grp * 2);
            const int b = ql / (keep * 128), r = (ql / 128) % keep, e = ql & 127, s = e >> 6, rem = (e & 63) * 4;
            v[u] = *(const u32x2*)(PROJ + ((size_t)b * T_SEQ + T_SEQ - keep + r) * NPROJ + C_AK + s * 768 + grp * 256 + rem); }
#pragma unroll
        for (int u = 0; u < 8; ++u) { const int q = cidx * 16384 + (i0 + u) * NTHR + tid;
            int grp, ql; if (q < 32768) { grp = 0; ql = q; } else if (q < 163840) { grp = 1; ql = q - 32768; } else { grp = 2; ql = q - 163840; }
            float* dst = p.out + (grp == 0 ? O_PKV0 : (grp == 1 ? O_PKV1 : O_PKV2));
            *(f32x4*)(dst + (size_t)ql * 4) = bf4_to_f4(v[u]); }
    }
}
__device__ __forceinline__ void pdc_item(const Params& p) {
    const bf16_t* PROJ = (const bf16_t*)(p.ws + W_PROJ);
    for (int i = opaque_tid(); i < 9216; i += NTHR) { const int b = i / 4608, j = (i / 1536) % 3, c = i % 1536;
        p.out[O_PDC + i] = bf2f(PROJ[((size_t)b * T_SEQ + T_SEQ - 3 + j) * NPROJ + C_DN + c]); }
}

template <bool FINAL>
__device__ __forceinline__ void phase_ln(const Params& p, const float* gam, const float* bet) {
    const int tid = opaque_tid(), lane = tid & 63, w = tid >> 6;
    const float* PRE = (const float*)(p.ws + W_PRE);
    float* H = (float*)(p.ws + W_H); bf16_t* HB = (bf16_t*)(p.ws + W_HB);
    f32x4 g4[4], b4[4];
#pragma unroll
    for (int i = 0; i < 4; ++i) { g4[i] = *(const f32x4*)(gam + 4 * (lane + 64 * i)); b4[i] = *(const f32x4*)(bet + 4 * (lane + 64 * i)); }
    for (int r = blockIdx.x * 8 + w; r < MROWS; r += gridDim.x * 8) {
        f32x4 x[4]; float s = 0.f;
#pragma unroll
        for (int i = 0; i < 4; ++i) { x[i] = *(const f32x4*)(PRE + (size_t)r * DM + 4 * (lane + 64 * i)); s += x[i][0] + x[i][1] + x[i][2] + x[i][3]; }
        const float mu = wave_sum(s) * (1.0f / 1024.0f); float v = 0.f;
#pragma unroll
        for (int i = 0; i < 4; ++i) { x[i] = x[i] - mu; v += x[i][0] * x[i][0] + x[i][1] * x[i][1] + x[i][2] * x[i][2] + x[i][3] * x[i][3]; }
        const float rs = rsqrtf(wave_sum(v) * (1.0f / 1024.0f) + 1e-5f);
#pragma unroll
        for (int i = 0; i < 4; ++i) { const f32x4 y = x[i] * rs * g4[i] + b4[i]; const int c = 4 * (lane + 64 * i);
            if (FINAL) { float* dst = r < NPROMPT ? p.out + O_Y + (size_t)r * DM : p.out + O_YS + (size_t)(r - NPROMPT) * DM; *(f32x4*)(dst + c) = y; }
            else { *(f32x4*)(H + (size_t)r * DM + c) = y; u32x2 o; o[0] = pk2(y[0], y[1]); o[1] = pk2(y[2], y[3]); *(u32x2*)(HB + (size_t)r * DM + c) = o;
                   if (r >= NPROMPT) *(f32x4*)((float*)(p.ws + W_PRE) + (size_t)r * DM + c) = y * ALPHA; } }
    }
}

__device__ __forceinline__ void unpack8(const u32x4 q, float* o) {
    const f32x4 t0 = bf4_to_f4((u32x2){q.x, q.y}), t1 = bf4_to_f4((u32x2){q.z, q.w});
#pragma unroll
    for (int j = 0; j < 4; ++j) { o[j] = t0[j]; o[4 + j] = t1[j]; }
}
__device__ __forceinline__ void phase_ffn_act(const Params& p) {
    const bf16_t* UP = (const bf16_t*)(p.ws + W_UP); bf16_t* ACT = (bf16_t*)(p.ws + W_ACT);
    const float* wc = p.in[19]; const float* bc = p.in[20];
    const int gtid = blockIdx.x * NTHR + opaque_tid(), gn = gridDim.x * NTHR;
    for (int idx = gtid; idx < 2048 * 352; idx += gn) {
        const int seg = idx / 352, c0 = (idx % 352) * 8, row0 = seg * 8, t0 = row0 & (T_SEQ - 1);
        float w0[8], w1[8], w2[8], bb[8];
#pragma unroll
        for (int j = 0; j < 8; ++j) { w0[j] = wc[c0 + j]; w1[j] = wc[DFF + c0 + j]; w2[j] = wc[2 * DFF + c0 + j]; bb[j] = bc[c0 + j]; }
        u32x4 ar[10], gr[8];
#pragma unroll
        for (int r = 0; r < 10; ++r) { const int t = t0 - 2 + r; ar[r] = (t >= 0) ? *(const u32x4*)(UP + (size_t)(row0 - 2 + r) * NUP + c0) : (u32x4){0u, 0u, 0u, 0u}; }
#pragma unroll
        for (int r = 0; r < 8; ++r) gr[r] = *(const u32x4*)(UP + (size_t)(row0 + r) * NUP + DFF + c0);
        float am2[8], am1[8], a0[8], gv[8];
        unpack8(ar[0], am2); unpack8(ar[1], am1);
#pragma unroll
        for (int r = 0; r < 8; ++r) {
            unpack8(ar[r + 2], a0); unpack8(gr[r], gv);
            unsigned o[4];
#pragma unroll
            for (int j = 0; j < 8; j += 2) {
                const float v0 = gelu_tanh(w0[j] * am2[j] + w1[j] * am1[j] + w2[j] * a0[j] + bb[j]) * gv[j];
                const float v1 = gelu_tanh(w0[j + 1] * am2[j + 1] + w1[j + 1] * am1[j + 1] + w2[j + 1] * a0[j + 1] + bb[j + 1]) * gv[j + 1];
                o[j >> 1] = pk2(v0, v1);
            }
            *(u32x4*)(ACT + (size_t)(row0 + r) * DFF + c0) = (u32x4){o[0], o[1], o[2], o[3]};
            if (t0 + r >= T_SEQ - 2) { float* d = p.out + O_PFC + ((size_t)(row0 >> 13) * 2 + (t0 + r - (T_SEQ - 2))) * DFF + c0;
#pragma unroll
                for (int j = 0; j < 8; ++j) d[j] = a0[j]; }
#pragma unroll
            for (int j = 0; j < 8; ++j) { am2[j] = am1[j]; am1[j] = a0[j]; }
        }
    }
    for (int idx = gtid; idx < NSAMP * 352; idx += gn) {
        const int b = idx / 352, c0 = (idx % 352) * 8; const size_t row = (size_t)NPROMPT + b;
        float a0[8], gv[8];
        unpack8(*(const u32x4*)(UP + row * NUP + c0), a0); unpack8(*(const u32x4*)(UP + row * NUP + DFF + c0), gv);
        const float* st = p.in[7] + (size_t)b * 2 * DFF + c0; float* d = p.out + O_SFC + (size_t)b * 2 * DFF + c0;
        unsigned o[4];
#pragma unroll
        for (int j = 0; j < 8; j += 2) {
            float r2[2];
#pragma unroll
            for (int q = 0; q < 2; ++q) { const int jj = j + q; const float am2 = st[jj], am1 = st[DFF + jj]; d[jj] = am1; d[DFF + jj] = a0[jj];
                r2[q] = gelu_tanh(wc[c0 + jj] * am2 + wc[DFF + c0 + jj] * am1 + wc[2 * DFF + c0 + jj] * a0[jj] + bc[c0 + jj]) * gv[jj]; }
            o[j >> 1] = pk2(r2[0], r2[1]);
        }
        *(u32x4*)(ACT + row * DFF + c0) = (u32x4){o[0], o[1], o[2], o[3]};
    }
}

constexpr int CH_P2_END = 0;
constexpr int IT_PDC = 0, IT_LAST = 1, IT_PKV = 25, IT_ATT = 67, IT_DEC = 323, IT_REC = 451, IT_END = 963;
constexpr int NSCAN = 64;
constexpr int CW_Q3 = 0, CW_Q2 = 16, CW_CHUNK = 32, CW_DONE = 48;
__device__ __forceinline__ unsigned ctl_ld(unsigned* p) { return __hip_atomic_load(p, __ATOMIC_RELAXED, __HIP_MEMORY_SCOPE_AGENT); }
__device__ __forceinline__ int queue_pop(unsigned* ctr, lds_t* L) {
    __syncthreads();
    if (threadIdx.x == 0) *(LAS int*)(L + LDS_BYTES - 16) = (int)atomicAdd(ctr, 1u);
    __syncthreads();
    const int item = *(LAS int*)(L + LDS_BYTES - 16);
    __syncthreads();
    return item;
}
__device__ __forceinline__ void copy_drain(const Params& p, lds_t* L, int limit) {
    unsigned* ctr = (unsigned*)(p.ws + W_CTL) + CW_CHUNK;
    for (;;) {
        __syncthreads();
        if (threadIdx.x == 0) { const unsigned cur = ctl_ld(ctr); *(LAS int*)(L + LDS_BYTES - 16) = (cur >= (unsigned)limit) ? NCHUNK : (int)atomicAdd(ctr, 1u); }
        __syncthreads();
        const int idx = *(LAS int*)(L + LDS_BYTES - 16);
        if (idx >= NCHUNK) break;
        kv_copy_chunk(p, idx);
    }
}
__device__ __forceinline__ void copy_fill(const Params& p, lds_t* L, int ph, int my_units, int total_units) {
    unsigned* ctr = (unsigned*)(p.ws + W_CTL) + CW_CHUNK; unsigned* done = (unsigned*)(p.ws + W_CTL) + CW_DONE + 8 * ph;
    if (threadIdx.x == 0) __hip_atomic_fetch_add(done, (unsigned)my_units, __ATOMIC_RELAXED, __HIP_MEMORY_SCOPE_AGENT);
    for (;;) {
        __syncthreads();
        if (threadIdx.x == 0) { const bool stop = ctl_ld(done) >= (unsigned)total_units || ctl_ld(ctr) >= (unsigned)NCHUNK; *(LAS int*)(L + LDS_BYTES - 16) = stop ? NCHUNK : (int)atomicAdd(ctr, 1u); }
        __syncthreads();
        const int idx = *(LAS int*)(L + LDS_BYTES - 16);
        if (idx >= NCHUNK) break;
        kv_copy_chunk(p, idx);
    }
}
__device__ __forceinline__ int count_units(const pg8::StaticOrder& S) { pg8::Unit u; int n = 0; while (S.next(n, u)) ++n; return n; }
__device__ __forceinline__ void phase_prep(const Params& p, lds_t* L) {
    unsigned* ctr = (unsigned*)(p.ws + W_CTL) + CW_Q2;
    for (;;) {
        const int item = queue_pop(ctr, L);
        if (item >= 1024) break;
        dn_prep_task(p, L, item);
    }
    copy_drain(p, L, CH_P2_END);
}
__device__ __forceinline__ void phase_mix(const Params& p, lds_t* L) {
    if (blockIdx.x < NSCAN) dn_scan(p, L, (blockIdx.x & 7) * 8 + (blockIdx.x >> 3));
    unsigned* ctr = (unsigned*)(p.ws + W_CTL) + CW_Q3;
    for (;;) {
        const int item = queue_pop(ctr, L);
        if (item >= IT_END) break;
        if (item < IT_LAST) pdc_item(p);
        else if (item < IT_PKV) kv_lastrow_item(p, item - IT_LAST);
        else if (item < IT_ATT) pkv_chunk(p, item - IT_PKV);
        else if (item < IT_DEC) attn_prompt_item(p, L, item - IT_ATT);
        else if (item < IT_REC) attn_decode_item(p, L, item - IT_DEC);
        else dn_rec_item(p, L, item - IT_REC);
    }
}

#define XB_TMO      128
#define XB_XCNT(j)  (256  + 64 * (j))
#define XB_XSUB(j)  (1280 + 64 * (j))
#define XB_XGEN(j)  (2304 + 64 * (j))
#define XB_TOP      3328
#define XB_TOPGEN   3392
#define XCD_BAR_WORDS 3456
#define XB_SPIN_CAP (1u << 18)
__device__ __forceinline__ unsigned xb_ld(unsigned* p)              { return __hip_atomic_load(p, __ATOMIC_RELAXED, __HIP_MEMORY_SCOPE_AGENT); }
__device__ __forceinline__ unsigned xb_add(unsigned* p, unsigned v) { return __hip_atomic_fetch_add(p, v, __ATOMIC_RELAXED, __HIP_MEMORY_SCOPE_AGENT); }
__device__ __forceinline__ unsigned xb_xcc_id() { return (unsigned)__builtin_amdgcn_s_getreg((3 << 11) | 20) & 0xFu; }
#define XB_SPIN(cond, bar) do { unsigned _sp = 0; while (cond) { __builtin_amdgcn_s_sleep(1); \
    if ((++_sp & 255u) == 0u) { if (xb_ld(&(bar)[XB_TMO])) break; if (_sp > XB_SPIN_CAP) { atomicAdd(&(bar)[XB_TMO], 1u); break; } } } } while (0)
struct XcdBarrier { unsigned* bar; unsigned x; volatile LAS unsigned* st; };
__device__ __forceinline__ XcdBarrier xcd_barrier_post(unsigned* bar, volatile LAS unsigned* st) {
    XcdBarrier b; b.bar = bar; b.x = xb_xcc_id(); b.st = st;
    if (threadIdx.x == 0) (void)xb_add(&bar[XB_XCNT(b.x)], 1u);
    return b;
}
__device__ __forceinline__ void xcd_barrier_complete(unsigned* bar, unsigned x, unsigned& nloc, unsigned& nx) {
    const unsigned G = gridDim.x * gridDim.y * gridDim.z;
    unsigned sum, cnt, mine, sp = 0u;
    for (;;) {
        sum = 0u; cnt = 0u; mine = 0u;
#pragma unroll
        for (unsigned j = 0; j < 16; ++j) { const unsigned c = xb_ld(&bar[XB_XCNT(j)]); sum += c; cnt += (c > 0u) ? 1u : 0u; mine = (j == x) ? c : mine; }
        if (sum == G) break;
        __builtin_amdgcn_s_sleep(1);
        if ((++sp & 255u) == 0u) { if (xb_ld(&bar[XB_TMO])) break; if (sp > XB_SPIN_CAP) { atomicAdd(&bar[XB_TMO], 1u); break; } }
    }
    nloc = mine > 0u ? mine : 1u; nx = cnt > 0u ? cnt : 1u;
}
__device__ __forceinline__ void xcd_barrier(const XcdBarrier& b) {
    asm volatile("s_waitcnt vmcnt(0)" ::: "memory");
    __syncthreads();
    if (threadIdx.x == 0) {
        unsigned* bar = b.bar;
        __builtin_amdgcn_s_waitcnt(0);
        unsigned nloc = b.st[0], nx = b.st[1];
        if (nloc == 0u) { xcd_barrier_complete(bar, b.x, nloc, nx); b.st[0] = nloc; b.st[1] = nx; }
        const unsigned old = xb_add(&bar[XB_XSUB(b.x)], 1u);
        const unsigned gen = old / nloc;
        if (old + 1u == (gen + 1u) * nloc) {
            __builtin_amdgcn_fence(__ATOMIC_RELEASE, "agent");
            asm volatile("s_waitcnt vmcnt(0)" ::: "memory");
            const unsigned og = xb_add(&bar[XB_TOP], 1u);
            const unsigned tg = og / nx;
            if (og + 1u == (tg + 1u) * nx) xb_add(&bar[XB_TOPGEN], 1u);
            else XB_SPIN(xb_ld(&bar[XB_TOPGEN]) == tg, bar);
            __builtin_amdgcn_fence(__ATOMIC_ACQUIRE, "agent");
            xb_add(&bar[XB_XGEN(b.x)], 1u);
            asm volatile("s_waitcnt vmcnt(0)" ::: "memory");
        } else {
            XB_SPIN(xb_ld(&bar[XB_XGEN(b.x)]) == gen, bar);
            __builtin_amdgcn_fence(__ATOMIC_ACQUIRE, "agent");
            asm volatile("s_waitcnt vmcnt(0)" ::: "memory");
        }
    }
    __syncthreads();
}

__global__ void __launch_bounds__(512, 2) fwd_megakernel(Params p) {
    extern __shared__ __attribute__((aligned(16))) unsigned char shm[];
    lds_t* L = (lds_t*)shm;
    cg::grid_group grid = cg::this_grid();
    const int G = gridDim.x, c = blockIdx.x;
    const bf16_t* XB = (const bf16_t*)(p.ws + W_XB);
    bf16_t* PROJ = (bf16_t*)(p.ws + W_PROJ);

    if (threadIdx.x < 4) *(LAS unsigned*)(L + LDS_BYTES - 48 + threadIdx.x * 4) = 0u;
    __syncthreads();
    const XcdBarrier xb = xcd_barrier_post((unsigned*)(p.ws + W_CTL), (volatile LAS unsigned*)(L + LDS_BYTES - 48));
    phase_convert(p, L);
    grid.sync();

    {
        constexpr int NCP1 = 23;
        pg8::StaticOrder S; S.init(MPAD, NPROJ, G - NCP1, c);
        pg8::Gemm g{XB, (const bf16_t*)(p.ws + W_WIN), MPAD, NPROJ, DM};
        pg8::EpiStoreBf16 E{PROJ, NPROJ};
        if (c < G - NCP1) { pg8::gemm_phase(L, g, S, E); copy_fill(p, L, 0, count_units(S), (MPAD / 256) * (NPROJ / 256)); }
        else copy_fill(p, L, 0, 0, (MPAD / 256) * (NPROJ / 256));
    }
    xcd_barrier(xb);
    phase_prep(p, L);
    xcd_barrier(xb);
    phase_mix(p, L);
    xcd_barrier(xb);
    for (int item = c; item < 256; item += G) dn_norm_item(p, item);
    xcd_barrier(xb);
    {
        pg8::StaticOrder S; S.init(MPAD, DM, G, c);
        pg8::Gemm g1{(const bf16_t*)(p.ws + W_OATT), (const bf16_t*)(p.ws + W_WAO), MPAD, DM, 256};
        pg8::EpiGate1 E1{(float*)(p.ws + W_T1), PROJ};
        pg8::gemm_phase(L, g1, S, E1);
        asm volatile("s_waitcnt vmcnt(0)" ::: "memory");
        __syncthreads();
        pg8::Gemm g2{(const bf16_t*)(p.ws + W_ODN), (const bf16_t*)(p.ws + W_WDO), MPAD, DM, 512};
        pg8::EpiGate2 E2{(bf16_t*)(p.ws + W_MRG), (const float*)(p.ws + W_T1), PROJ};
        pg8::gemm_phase(L, g2, S, E2);
        copy_fill(p, L, 1, count_units(S), (MPAD / 256) * (DM / 256));
    }
    xcd_barrier(xb);
    {
        pg8::StaticOrder S; S.init(NPROMPT, DM, G, c);
        pg8::Gemm g{(const bf16_t*)(p.ws + W_MRG), (const bf16_t*)(p.ws + W_WO), NPROMPT, DM, DM};
        pg8::EpiRes E{(float*)(p.ws + W_PRE), p.in[0], p.in[1]};
        pg8::gemm_phase(L, g, S, E);
        {
            pg8::StaticOrder S2; S2.init(256, 4 * DM, G, c);
            pg8::Gemm g2{(const bf16_t*)(p.ws + W_MRG) + (size_t)NPROMPT * DM, (const bf16_t*)(p.ws + W_WO), 256, 4 * DM, 256, DM, 4};
            pg8::EpiAtomic E2{(float*)(p.ws + W_PRE), NPROMPT, 4};
            pg8::gemm_phase(L, g2, S2, E2);
        }
        copy_fill(p, L, 2, 1, 256);
    }
    xcd_barrier(xb);
    phase_ln<false>(p, p.in[16], p.in[17]);
    xcd_barrier(xb);
    {
        constexpr int NCP7 = 17;
        pg8::StaticOrder S; S.init(MPAD, NUP, G - NCP7, c);
        pg8::Gemm g{(const bf16_t*)(p.ws + W_HB), (const bf16_t*)(p.ws + W_WUP), MPAD, NUP, DM};
        pg8::EpiStoreBf16 E{(bf16_t*)(p.ws + W_UP), NUP};
        if (c < G - NCP7) { pg8::gemm_phase(L, g, S, E); copy_fill(p, L, 3, count_units(S), (MPAD / 256) * (NUP / 256)); }
        else copy_fill(p, L, 3, 0, (MPAD / 256) * (NUP / 256));
    }
    xcd_barrier(xb);
    phase_ffn_act(p);
    xcd_barrier(xb);
    {
        pg8::StaticOrder S; S.init(NPROMPT, DM, G, c);
        pg8::Gemm g{(const bf16_t*)(p.ws + W_ACT), (const bf16_t*)(p.ws + W_WDN), NPROMPT, DM, DFF};
        pg8::EpiRes E{(float*)(p.ws + W_PRE), (const float*)(p.ws + W_H), (const float*)(p.ws + W_H) + (size_t)NPROMPT * DM};
        pg8::gemm_phase(L, g, S, E);
        {
            pg8::StaticOrder S2; S2.init(256, 11 * DM, G, c);
            pg8::Gemm g2{(const bf16_t*)(p.ws + W_ACT) + (size_t)NPROMPT * DFF, (const bf16_t*)(p.ws + W_WDN), 256, 11 * DM, 256, DFF, 4};
            pg8::EpiAtomic E2{(float*)(p.ws + W_PRE), NPROMPT, 4};
            pg8::gemm_phase(L, g2, S2, E2);
        }
        copy_fill(p, L, 4, 1, 256);
        copy_drain(p, L, NCHUNK);
    }
    xcd_barrier(xb);
    phase_ln<true>(p, p.in[22], p.in[23]);
}

extern "C" void kernel_launch(void* const* d_in, const int* in_sizes, int n_in, void* d_out, int out_size, void* d_ws, size_t ws_size, hipStream_t stream) {
    static int grid = 0;
    if (grid == 0) {
        if (n_in != 24 || (size_t)out_size != O_END || ws_size < W_END) { fprintf(stderr, "kernel_launch: unexpected shapes (n_in %d out %d ws %zu need %zu)\n", n_in, out_size, ws_size, (size_t)W_END); grid = -1; return; }
        int dev = 0, cus = 0, per_cu = 0;
        hipGetDevice(&dev);
        hipDeviceGetAttribute(&cus, hipDeviceAttributeMultiprocessorCount, dev);
        if (hipFuncSetAttribute((const void*)fwd_megakernel, hipFuncAttributeMaxDynamicSharedMemorySize, LDS_BYTES) != hipSuccess) { fprintf(stderr, "kernel_launch: hipFuncSetAttribute failed\n"); grid = -1; return; }
        if (hipOccupancyMaxActiveBlocksPerMultiprocessor(&per_cu, (const void*)fwd_megakernel, NTHR, LDS_BYTES) != hipSuccess || per_cu < 1) { fprintf(stderr, "kernel_launch: occupancy query says %d\n", per_cu); per_cu = 1; }
        (void)hipGetLastError();
        grid = cus;
    }
    if (grid < 0) return;
    hipMemsetAsync((char*)d_ws + W_CTL, 0, 16384, stream);
    Params p{};
    for (int i = 0; i < 24; ++i) p.in[i] = (const float*)d_in[i];
    p.out = (float*)d_out; p.ws = (unsigned char*)d_ws;
    void* args[] = {&p};
    hipError_t e = hipLaunchCooperativeKernel((const void*)fwd_megakernel, dim3(grid), dim3(NTHR), args, LDS_BYTES, stream);
    if (e != hipSuccess) fprintf(stderr, "cooperative launch failed: %s (grid %d)\n", hipGetErrorString(e), grid);
}
```

```cpp
#include <hip/hip_runtime.h>
#include <hip/hip_cooperative_groups.h>
#include <cstdio>
namespace cg = cooperative_groups;

#define LAS __attribute__((address_space(3)))
typedef LAS unsigned char lds_t;
typedef unsigned short bf16_t;
typedef short bf16x8 __attribute__((ext_vector_type(8)));
typedef float f32x4 __attribute__((ext_vector_type(4)));
typedef unsigned u32x4 __attribute__((ext_vector_type(4)));
typedef unsigned u32x2 __attribute__((ext_vector_type(2)));

constexpr int T_SEQ = 8192, NPROMPT = 16384, NSAMP = 128, MROWS = 16512, MPAD = 16640;
constexpr int DM = 1024, NPROJ = 6400, INW = 6408, DFF = 2816, NUP = 5632;
constexpr int C_AK = 768, C_AV = 1536, C_DN = 2304, C_Z = 3840, C_GA = 4352, C_GD = 5376;
constexpr float ALPHA = 1.189207115002721f;
constexpr int LDS_BYTES = 155648;
constexpr int NTHR = 512;

constexpr size_t O_Y = 0, O_YS = 16777216, O_PKV0 = O_YS + 131072, O_PKV1 = O_PKV0 + 131072, O_PKV2 = O_PKV1 + 524288,
                 O_PDC = O_PKV2 + 2097152, O_PDS = O_PDC + 9216, O_PFC = O_PDS + 131072, O_SKV0 = O_PFC + 11264,
                 O_SKV1 = O_SKV0 + 8388608, O_SKV2 = O_SKV1 + 33554432, O_SDC = O_SKV2 + 134217728, O_SDS = O_SDC + 589824,
                 O_SFC = O_SDS + 8388608, O_END = O_SFC + 720896;

constexpr size_t al256(size_t x) { return (x + 255) & ~(size_t)255; }
constexpr size_t W_CTL = 0;
constexpr size_t W_XB = 16384;
constexpr size_t W_WIN = W_XB + al256((size_t)MPAD * DM * 2);
constexpr size_t W_WAO = W_WIN + al256((size_t)NPROJ * DM * 2);
constexpr size_t W_WDO = W_WAO + al256((size_t)DM * 256 * 2);
constexpr size_t W_WO = W_WDO + al256((size_t)DM * 512 * 2);
constexpr size_t W_WUP = W_WO + al256((size_t)DM * DM * 2);
constexpr size_t W_WDN = W_WUP + al256((size_t)NUP * DM * 2);
constexpr size_t W_AB = W_WDN + al256((size_t)DM * DFF * 2);
constexpr size_t W_PROJ = W_AB + al256((size_t)MROWS * 8 * 4);
constexpr size_t W_OG = W_PROJ + al256((size_t)MPAD * NPROJ * 2);
constexpr size_t W_LSE = W_OG + al256((size_t)3 * NPROMPT * 256 * 4);
constexpr size_t W_OATT = W_LSE + al256((size_t)3 * NPROMPT * 4 * 4);
constexpr size_t W_ODN = W_OATT + al256((size_t)MPAD * 256 * 2);
constexpr size_t TASK_BYTES = 90368;
constexpr size_t W_DNT = W_ODN + al256((size_t)MPAD * 512 * 2);
constexpr size_t W_GL = W_DNT + al256((size_t)1024 * TASK_BYTES);
constexpr size_t W_T1 = W_GL + al256(1024 * 4);
constexpr size_t W_MRG = W_T1 + al256((size_t)MPAD * DM * 4);
constexpr size_t W_PRE = W_MRG + al256((size_t)MPAD * DM * 2);
constexpr size_t W_H = W_PRE + al256((size_t)MPAD * DM * 4);
constexpr size_t W_HB = W_H + al256((size_t)MPAD * DM * 4);
constexpr size_t W_UP = W_HB + al256((size_t)MPAD * DM * 2);
constexpr size_t W_ACT = W_UP + al256((size_t)MPAD * NUP * 2);
constexpr size_t W_OSC = W_ACT + al256((size_t)MPAD * DFF * 2);
constexpr size_t W_END = W_OSC + al256((size_t)1024 * 32768);

struct Params {
    const float* in[24];
    float* out;
    unsigned char* ws;
};

__device__ __forceinline__ float bf2f(bf16_t b) { return __uint_as_float(((unsigned)b) << 16); }
__device__ __forceinline__ bf16_t f2bf(float f) { unsigned u = __float_as_uint(f); u += 0x7FFFu + ((u >> 16) & 1u); return (bf16_t)(u >> 16); }
__device__ __forceinline__ unsigned pk2(float lo, float hi) { unsigned r; asm("v_cvt_pk_bf16_f32 %0, %1, %2" : "=v"(r) : "v"(lo), "v"(hi)); return r; }
__device__ __forceinline__ float sigmoidf_(float x) { return 1.0f / (1.0f + __expf(-x)); }
__device__ __forceinline__ float siluf_(float x) { return x / (1.0f + __expf(-x)); }
__device__ __forceinline__ float softplusf_(float x) { return x > 20.0f ? x : log1pf(__expf(x)); }
__device__ __forceinline__ float gelu_tanh(float x) { const float u = 0.7978845608028654f * (x + 0.044715f * x * x * x); return x / (1.0f + __expf(-2.0f * u)); }
__device__ __forceinline__ float wave_sum(float v) {
#pragma unroll
    for (int o = 32; o > 0; o >>= 1) v += __shfl_xor(v, o, 64);
    return v;
}
__device__ __forceinline__ float wave_max(float v) {
#pragma unroll
    for (int o = 32; o > 0; o >>= 1) v = fmaxf(v, __shfl_xor(v, o, 64));
    return v;
}
__device__ __forceinline__ float sum16(float v) {
#pragma unroll
    for (int o = 8; o > 0; o >>= 1) v += __shfl_xor(v, o, 64);
    return v;
}
__device__ __forceinline__ f32x4 bf4_to_f4(u32x2 w) {
    f32x4 r; r[0] = __uint_as_float(w[0] << 16); r[1] = __uint_as_float(w[0] & 0xFFFF0000u); r[2] = __uint_as_float(w[1] << 16); r[3] = __uint_as_float(w[1] & 0xFFFF0000u); return r;
}
#define WSYNC() do { asm volatile("" ::: "memory"); __builtin_amdgcn_wave_barrier(); asm volatile("" ::: "memory"); } while (0)
__device__ __forceinline__ int opaque_tid() { int t = threadIdx.x; asm volatile("" : "+v"(t)); return t; }
__device__ __forceinline__ f32x4 mfma16(bf16x8 a, bf16x8 b, f32x4 c) { return __builtin_amdgcn_mfma_f32_16x16x32_bf16(a, b, c, 0, 0, 0); }

namespace pg8 {
constexpr int BM = 256, BK = 64, HALF = 128, HTB = HALF * BK * 2, STAGE_BYTES = 8 * HTB, NXCD = 8, WGM = 8;
__device__ __forceinline__ int lds_byte(int r, int c) { const int st = (r >> 4) * 2 + (c >> 5), rr = r & 15, cc = c & 31, ob = rr * 64 + cc * 2; return st * 1024 + (ob ^ (((ob >> 9) & 1) << 5)); }
__device__ __forceinline__ void stage_rc(int b, int& R, int& C) { const int st = b / 1024, sb = b % 1024, swz = sb ^ (((sb >> 9) & 1) << 5); R = (st >> 1) * 16 + swz / 64; C = (st & 1) * 32 + (swz % 64) / 2; }
__device__ __forceinline__ int perm32(int rho) { const int n = rho >> 4, i = rho & 15; return 8 * (i >> 2) + 4 * n + (i & 3); }
struct Unit { int pm, pn; };
struct Gemm { const bf16_t* A; const bf16_t* Bt; int M, N, K; int ld = 0, ncol = 0; };
struct StaticOrder {
    int nM, nN, nwg, G, c;
    __device__ __forceinline__ void init(int M, int N, int G_, int c_) { nM = M / BM; nN = N / BM; nwg = nM * nN; G = G_; c = c_; }
    __device__ __forceinline__ bool next(int i, Unit& u) const {
        const long L = (long)i * G + c; if (L >= nwg) return false;
        int wgid = (int)L; { const int q = nwg / NXCD, r = nwg % NXCD, xcd = wgid % NXCD, off = wgid / NXCD; wgid = (xcd < r ? xcd * (q + 1) : r * (q + 1) + (xcd - r) * q) + off; }
        const int nig = WGM * nN, gid = wgid / nig, fm = gid * WGM, gsz = (nM - fm) < WGM ? (nM - fm) : WGM;
        u.pm = fm + ((wgid % nig) % gsz); u.pn = (wgid % nig) / gsz; return true;
    }
};
__device__ __forceinline__ unsigned cvt_pk_bf16(float lo, float hi) { unsigned r; asm volatile("v_cvt_pk_bf16_f32 %0, %1, %2" : "=v"(r) : "v"(lo), "v"(hi)); return r; }

template <class Epi>
__device__ __forceinline__ void gemm_phase(lds_t* lds, const Gemm g, const StaticOrder& S, const Epi& E) {
    const int tid = opaque_tid(), wid = __builtin_amdgcn_readfirstlane(tid >> 6), lane = tid & 63, wr = wid >> 2, wc = wid & 3, fr = lane & 15, fq = lane >> 4;
    const int K = g.K, nt = K / BK, ld = g.ld ? g.ld : g.K, ncol = g.ncol;
    unsigned voffA[2], voffB[2];
#pragma unroll
    for (int i = 0; i < 2; ++i) { int R, C; stage_rc(tid * 16 + i * 8192, R, C); const int Rb = Epi::PERM ? ((R & ~31) + perm32(R & 31)) : R;
        voffA[i] = (unsigned)(R * ld + C) * 2u; voffB[i] = (unsigned)(Rb * ld + C) * 2u; }
    const size_t kstep = (size_t)(BK * 2);
    const size_t hstep = (size_t)HALF * ld * 2;
    const size_t tstep = 2 * hstep;
    const unsigned ldsw = (unsigned)wid * 1024u;
    const int aoff = lds_byte(wr * 64 + fr, fq * 8), boff = lds_byte(wc * 32 + fr, fq * 8);
#define PG8_SA(b, h) (((b) * 2 + (h)) * HTB)
#define PG8_SB(b, h) ((4 + (b) * 2 + (h)) * HTB)
#define PG8_STAGE(bufoff, gbase, voff) do { _Pragma("unroll") for (int _i = 0; _i < 2; ++_i) \
        __builtin_amdgcn_global_load_lds((const unsigned*)((const char*)(gbase) + (voff)[_i]), (LAS unsigned*)(lds + (bufoff) + ldsw + _i * 8192), 16, 0, 0); } while (0)
#define PG8_LDA(dst, b, h) do { _Pragma("unroll") for (int m = 0; m < 4; ++m) _Pragma("unroll") for (int k = 0; k < 2; ++k) dst[m][k] = *(const LAS bf16x8*)(lds + PG8_SA(b, h) + aoff + m * 2048 + k * 1024); } while (0)
#define PG8_LDB(dst, b, h) do { _Pragma("unroll") for (int n = 0; n < 2; ++n) _Pragma("unroll") for (int k = 0; k < 2; ++k) dst[n][k] = *(const LAS bf16x8*)(lds + PG8_SB(b, h) + boff + n * 2048 + k * 1024); } while (0)
#define PG8_MMA(ai, bj, At, Bt) do { __builtin_amdgcn_s_setprio(1); _Pragma("unroll") for (int m = 0; m < 4; ++m) _Pragma("unroll") for (int n = 0; n < 2; ++n) _Pragma("unroll") for (int k = 0; k < 2; ++k) \
        acc[ai][bj][m][n] = __builtin_amdgcn_mfma_f32_16x16x32_bf16(Bt[n][k], At[m][k], acc[ai][bj][m][n], 0, 0, 0); __builtin_amdgcn_s_setprio(0); } while (0)
#define PG8_WAIT_V(n) asm volatile("s_waitcnt vmcnt(" #n ")" ::: "memory")
#define PG8_WAIT_L(n) asm volatile("s_waitcnt lgkmcnt(" #n ")" ::: "memory")
#define PG8_BAR __builtin_amdgcn_s_barrier()
#define PG8_SCHED __builtin_amdgcn_sched_barrier(0)
    Unit cur, nxt; int ui = 0;
    if (!S.next(0, cur)) return;
    f32x4 acc[2][2][4][2];
#pragma unroll
    for (int a = 0; a < 2; ++a)
#pragma unroll
        for (int b = 0; b < 2; ++b)
#pragma unroll
            for (int m = 0; m < 4; ++m)
#pragma unroll
                for (int n = 0; n < 2; ++n) acc[a][b][m][n] = (f32x4){0.f, 0.f, 0.f, 0.f};
    bf16x8 At[4][2], B0[2][2], B1[2][2];
#define PG8_ABASE(u) ((const char*)g.A + (size_t)(u).pm * tstep + (ncol ? (size_t)((u).pn / ncol) * K * 2 : (size_t)0))
#define PG8_BBASE(u) ((const char*)g.Bt + (ncol ? (size_t)((u).pn % ncol) * tstep + (size_t)((u).pn / ncol) * K * 2 : (size_t)(u).pn * tstep))
    const char* cA = PG8_ABASE(cur); const char* cB = PG8_BBASE(cur);
    PG8_STAGE(PG8_SB(0, 0), cB, voffB); PG8_STAGE(PG8_SA(0, 0), cA, voffA); PG8_STAGE(PG8_SB(0, 1), cB + hstep, voffB); PG8_STAGE(PG8_SA(0, 1), cA + hstep, voffA);
    if (wr == 1) PG8_BAR;
    PG8_WAIT_V(4); PG8_BAR;
    PG8_STAGE(PG8_SB(1, 0), cB + kstep, voffB); PG8_STAGE(PG8_SA(1, 0), cA + kstep, voffA); PG8_STAGE(PG8_SB(1, 1), cB + hstep + kstep, voffB);
    PG8_WAIT_V(6); PG8_BAR;
    for (;;) {
        const bool has_next = S.next(ui + 1, nxt);
        const char* nA = has_next ? PG8_ABASE(nxt) : cA; const char* nB = has_next ? PG8_BBASE(nxt) : cB;
        for (int t = 0; t < nt; t += 2) {
            const bool last = (t == nt - 2);
            const char* a1 = cA + (size_t)(t + 1) * kstep;
            const char* a2 = last ? nA : cA + (size_t)(t + 2) * kstep; const char* b2 = last ? nB : cB + (size_t)(t + 2) * kstep;
            const char* a3 = a2 + kstep; const char* b3 = b2 + kstep;
            PG8_LDB(B0, 0, 0); PG8_SCHED; PG8_LDA(At, 0, 0); PG8_STAGE(PG8_SA(1, 1), a1 + hstep, voffA);
            PG8_WAIT_L(8); PG8_BAR; PG8_WAIT_L(0); PG8_MMA(0, 0, At, B0); PG8_BAR; PG8_SCHED;
            PG8_LDB(B1, 0, 1); PG8_STAGE(PG8_SB(0, 0), b2, voffB);
            PG8_BAR; PG8_WAIT_L(0); PG8_MMA(0, 1, At, B1); PG8_BAR;
            PG8_LDA(At, 0, 1); PG8_STAGE(PG8_SA(0, 0), a2, voffA);
            PG8_BAR; PG8_WAIT_L(0); PG8_MMA(1, 0, At, B0); PG8_BAR; PG8_SCHED;
            PG8_STAGE(PG8_SB(0, 1), b2 + hstep, voffB);
            PG8_WAIT_V(6); PG8_BAR; PG8_MMA(1, 1, At, B1); PG8_BAR;
            PG8_LDB(B0, 1, 0); PG8_SCHED; PG8_LDA(At, 1, 0); PG8_STAGE(PG8_SA(0, 1), a2 + hstep, voffA);
            PG8_WAIT_L(8); PG8_BAR; PG8_WAIT_L(0); PG8_MMA(0, 0, At, B0); PG8_BAR; PG8_SCHED;
            PG8_LDB(B1, 1, 1); PG8_STAGE(PG8_SB(1, 0), b3, voffB);
            PG8_BAR; PG8_WAIT_L(0); PG8_MMA(0, 1, At, B1); PG8_BAR;
            PG8_LDA(At, 1, 1); PG8_STAGE(PG8_SA(1, 0), a3, voffA);
            PG8_BAR; PG8_WAIT_L(0); PG8_MMA(1, 0, At, B0); PG8_BAR; PG8_SCHED;
            PG8_STAGE(PG8_SB(1, 1), b3 + hstep, voffB);
            PG8_WAIT_V(6); PG8_BAR; PG8_MMA(1, 1, At, B1); PG8_BAR;
        }
        E(acc, cur, wr, wc, fr, fq);
        if (!has_next) break;
#pragma unroll
        for (int a = 0; a < 2; ++a)
#pragma unroll
            for (int b = 0; b < 2; ++b)
#pragma unroll
                for (int m = 0; m < 4; ++m)
#pragma unroll
                    for (int n = 0; n < 2; ++n) acc[a][b][m][n] = (f32x4){0.f, 0.f, 0.f, 0.f};
        cur = nxt; cA = nA; cB = nB; ++ui;
    }
    PG8_WAIT_V(0);
    if (wr == 0) PG8_BAR;
    PG8_BAR;
#undef PG8_ABASE
#undef PG8_BBASE
#undef PG8_SA
#undef PG8_SB
#undef PG8_STAGE
#undef PG8_LDA
#undef PG8_LDB
#undef PG8_MMA
#undef PG8_WAIT_V
#undef PG8_WAIT_L
#undef PG8_BAR
#undef PG8_SCHED
}

struct EpiStoreBf16 {
    static constexpr bool PERM = true;
    bf16_t* O; int ldc;
    __device__ __forceinline__ void operator()(const f32x4 (&acc)[2][2][4][2], const Unit& u, int wr, int wc, int fr, int fq) const {
        const int row0 = u.pm * BM + wr * 64 + fr, col0 = u.pn * BM + wc * 32 + 8 * fq;
#pragma unroll
        for (int ai = 0; ai < 2; ++ai)
#pragma unroll
            for (int m = 0; m < 4; ++m) { bf16_t* rowp = O + (size_t)(row0 + ai * HALF + m * 16) * ldc + col0;
#pragma unroll
                for (int bj = 0; bj < 2; ++bj) { const f32x4 v0 = acc[ai][bj][m][0], v1 = acc[ai][bj][m][1];
                    u32x4 w; w.x = cvt_pk_bf16(v0[0], v0[1]); w.y = cvt_pk_bf16(v0[2], v0[3]); w.z = cvt_pk_bf16(v1[0], v1[1]); w.w = cvt_pk_bf16(v1[2], v1[3]);
                    *(u32x4*)(rowp + bj * HALF) = w; } }
    }
};
struct EpiGate1 {
    static constexpr bool PERM = false;
    float* T1; const bf16_t* PROJ;
    __device__ __forceinline__ void operator()(const f32x4 (&acc)[2][2][4][2], const Unit& u, int wr, int wc, int fr, int fq) const {
        const int row0 = u.pm * BM + wr * 64 + fr, col0 = u.pn * BM + wc * 32 + 4 * fq;
#pragma unroll
        for (int m = 0; m < 4; ++m) {
            u32x2 gt[2][2][2];
#pragma unroll
            for (int ai = 0; ai < 2; ++ai)
#pragma unroll
                for (int bj = 0; bj < 2; ++bj)
#pragma unroll
                    for (int n = 0; n < 2; ++n) gt[ai][bj][n] = *(const u32x2*)(PROJ + (size_t)(row0 + ai * HALF + m * 16) * NPROJ + C_GA + col0 + bj * HALF + n * 16);
#pragma unroll
            for (int ai = 0; ai < 2; ++ai)
#pragma unroll
                for (int bj = 0; bj < 2; ++bj)
#pragma unroll
                    for (int n = 0; n < 2; ++n) { const f32x4 g = bf4_to_f4(gt[ai][bj][n]); const f32x4 a = acc[ai][bj][m][n]; f32x4 o;
#pragma unroll
                        for (int j = 0; j < 4; ++j) o[j] = a[j] * sigmoidf_(g[j]);
                        *(f32x4*)(T1 + (size_t)(row0 + ai * HALF + m * 16) * DM + col0 + bj * HALF + n * 16) = o; }
        }
    }
};
struct EpiGate2 {
    static constexpr bool PERM = false;
    bf16_t* MRG; const float* T1; const bf16_t* PROJ;
    __device__ __forceinline__ void operator()(const f32x4 (&acc)[2][2][4][2], const Unit& u, int wr, int wc, int fr, int fq) const {
        const int row0 = u.pm * BM + wr * 64 + fr, col0 = u.pn * BM + wc * 32 + 4 * fq;
#pragma unroll
        for (int m = 0; m < 4; ++m) {
            u32x2 gt[2][2][2]; f32x4 t1[2][2][2];
#pragma unroll
            for (int ai = 0; ai < 2; ++ai)
#pragma unroll
                for (int bj = 0; bj < 2; ++bj)
#pragma unroll
                    for (int n = 0; n < 2; ++n) { const size_t row = (size_t)(row0 + ai * HALF + m * 16); const int col = col0 + bj * HALF + n * 16;
                        gt[ai][bj][n] = *(const u32x2*)(PROJ + row * NPROJ + C_GD + col); t1[ai][bj][n] = *(const f32x4*)(T1 + row * DM + col); }
#pragma unroll
            for (int ai = 0; ai < 2; ++ai)
#pragma unroll
                for (int bj = 0; bj < 2; ++bj)
#pragma unroll
                    for (int n = 0; n < 2; ++n) { const f32x4 g = bf4_to_f4(gt[ai][bj][n]); const f32x4 a = acc[ai][bj][m][n]; f32x4 o;
#pragma unroll
                        for (int j = 0; j < 4; ++j) o[j] = t1[ai][bj][n][j] + a[j] * sigmoidf_(g[j]);
                        u32x2 w; w[0] = cvt_pk_bf16(o[0], o[1]); w[1] = cvt_pk_bf16(o[2], o[3]);
                        *(u32x2*)(MRG + (size_t)(row0 + ai * HALF + m * 16) * DM + col0 + bj * HALF + n * 16) = w; }
        }
    }
};
struct EpiRes {
    static constexpr bool PERM = false;
    float* PRE; const float* resA; const float* resB;
    __device__ __forceinline__ void operator()(const f32x4 (&acc)[2][2][4][2], const Unit& u, int wr, int wc, int fr, int fq) const {
        const int row0 = u.pm * BM + wr * 64 + fr, col0 = u.pn * BM + wc * 32 + 4 * fq;
#pragma unroll
        for (int m = 0; m < 4; ++m) {
            f32x4 rv[2][2][2];
#pragma unroll
            for (int ai = 0; ai < 2; ++ai) { const int row = row0 + ai * HALF + m * 16; const int rc = row < MROWS ? row : 0;
                const float* rp = rc < NPROMPT ? resA + (size_t)rc * DM : resB + (size_t)(rc - NPROMPT) * DM;
#pragma unroll
                for (int bj = 0; bj < 2; ++bj)
#pragma unroll
                    for (int n = 0; n < 2; ++n) rv[ai][bj][n] = *(const f32x4*)(rp + col0 + bj * HALF + n * 16); }
#pragma unroll
            for (int ai = 0; ai < 2; ++ai) { const int row = row0 + ai * HALF + m * 16;
                if (row < MROWS) {
#pragma unroll
                    for (int bj = 0; bj < 2; ++bj)
#pragma unroll
                        for (int n = 0; n < 2; ++n) { const f32x4 a = acc[ai][bj][m][n]; f32x4 o;
#pragma unroll
                            for (int j = 0; j < 4; ++j) o[j] = ALPHA * rv[ai][bj][n][j] + a[j];
                            *(f32x4*)(PRE + (size_t)row * DM + col0 + bj * HALF + n * 16) = o; } } }
        }
    }
};
struct EpiAtomic {
    static constexpr bool PERM = false;
    float* PRE; int row_base, ncol;
    __device__ __forceinline__ void operator()(const f32x4 (&acc)[2][2][4][2], const Unit& u, int wr, int wc, int fr, int fq) const {
        const int row0 = row_base + u.pm * BM + wr * 64 + fr, col0 = (u.pn % ncol) * BM + wc * 32 + 4 * fq;
#pragma unroll
        for (int ai = 0; ai < 2; ++ai)
#pragma unroll
            for (int m = 0; m < 4; ++m) { const int row = row0 + ai * HALF + m * 16;
                if (row < MROWS) {
#pragma unroll
                    for (int bj = 0; bj < 2; ++bj)
#pragma unroll
                        for (int n = 0; n < 2; ++n) { float* d = PRE + (size_t)row * DM + col0 + bj * HALF + n * 16;
#pragma unroll
                            for (int j = 0; j < 4; ++j) atomicAdd(d + j, acc[ai][bj][m][n][j]); } } }
    }
};
}

__device__ __forceinline__ void phase_convert(const Params& p, lds_t* L) {
    const int tid = opaque_tid(), lane = tid & 63, w = tid >> 6, bid = blockIdx.x, nb = gridDim.x;
    const float* w_in = p.in[8];
    for (int i = tid; i < 1024 * 8; i += NTHR) { const int k = i >> 3, c = i & 7; *(LAS float*)(L + (c * 1024 + k) * 4) = w_in[(size_t)k * INW + 4352 + c]; }
    __syncthreads();
    bf16_t* XB = (bf16_t*)(p.ws + W_XB); float* AB = (float*)(p.ws + W_AB);
    for (int r = bid * 8 + w; r < MPAD; r += nb * 8) {
        if (r >= MROWS) {
#pragma unroll
            for (int i = 0; i < 4; ++i) *(u32x2*)(XB + (size_t)r * DM + 4 * (lane + 64 * i)) = (u32x2){0u, 0u};
            continue;
        }
        const float* xr = r < NPROMPT ? p.in[0] + (size_t)r * DM : p.in[1] + (size_t)(r - NPROMPT) * DM;
        float a8[8];
#pragma unroll
        for (int c = 0; c < 8; ++c) a8[c] = 0.f;
#pragma unroll
        for (int i = 0; i < 4; ++i) {
            const int k4 = lane + 64 * i; const f32x4 xv = *(const f32x4*)(xr + 4 * k4);
            u32x2 o; o[0] = pk2(xv[0], xv[1]); o[1] = pk2(xv[2], xv[3]);
            *(u32x2*)(XB + (size_t)r * DM + 4 * k4) = o;
            if (r >= NPROMPT) *(f32x4*)((float*)(p.ws + W_PRE) + (size_t)r * DM + 4 * k4) = xv * ALPHA;
#pragma unroll
            for (int c = 0; c < 8; ++c) { const f32x4 wv = *(const LAS f32x4*)(L + (c * 1024 + 4 * k4) * 4); a8[c] += xv[0] * wv[0] + xv[1] * wv[1] + xv[2] * wv[2] + xv[3] * wv[3]; }
        }
#pragma unroll
        for (int c = 0; c < 8; ++c) a8[c] = wave_sum(a8[c]);
        if (lane == 0) {
#pragma unroll
            for (int c = 0; c < 8; ++c) AB[(size_t)r * 8 + c] = a8[c];
        }
    }
    {
        bf16_t* OATT = (bf16_t*)(p.ws + W_OATT); bf16_t* ODN = (bf16_t*)(p.ws + W_ODN);
        for (int i = bid * NTHR + tid; i < 128 * 256 / 2; i += nb * NTHR) ((unsigned*)(OATT + (size_t)MROWS * 256))[i] = 0u;
        for (int i = bid * NTHR + tid; i < 128 * 512 / 2; i += nb * NTHR) ((unsigned*)(ODN + (size_t)MROWS * 512))[i] = 0u;
    }
    const int TOFF = 32768;
    for (int tix = bid; tix < 4160; tix += nb) {
        const float* src; bf16_t* dst; int ld, K, kt, ntile, ncoloff = 0;
        if (tix < 1600) { src = p.in[8]; dst = (bf16_t*)(p.ws + W_WIN); ld = INW; K = 1024; kt = tix / 100; ntile = tix % 100; ncoloff = (ntile * 64 >= 4352) ? 8 : 0; }
        else if (tix < 3008) { const int t = tix - 1600; src = p.in[18]; dst = (bf16_t*)(p.ws + W_WUP); ld = NUP; K = 1024; kt = t / 88; ntile = t % 88; }
        else if (tix < 3712) { const int t = tix - 3008; src = p.in[21]; dst = (bf16_t*)(p.ws + W_WDN); ld = 1024; K = DFF; kt = t / 16; ntile = t % 16; }
        else if (tix < 3968) { const int t = tix - 3712; src = p.in[15]; dst = (bf16_t*)(p.ws + W_WO); ld = 1024; K = 1024; kt = t / 16; ntile = t % 16; }
        else if (tix < 4032) { const int t = tix - 3968; src = p.in[13]; dst = (bf16_t*)(p.ws + W_WAO); ld = 1024; K = 256; kt = t / 16; ntile = t % 16; }
        else { const int t = tix - 4032; src = p.in[14]; dst = (bf16_t*)(p.ws + W_WDO); ld = 1024; K = 512; kt = t / 16; ntile = t % 16; }
        __syncthreads();
#pragma unroll
        for (int e = 0; e < 8; ++e) { const int idx = tid + NTHR * e, r = idx >> 6, c = idx & 63;
            *(LAS float*)(L + TOFF + (r * 65 + c) * 4) = src[(size_t)(kt * 64 + r) * ld + ntile * 64 + ncoloff + c]; }
        __syncthreads();
#pragma unroll
        for (int e = 0; e < 8; ++e) { const int idx = tid + NTHR * e, r = idx >> 6, c = idx & 63;
            dst[(size_t)(ntile * 64 + r) * K + kt * 64 + c] = f2bf(*(const LAS float*)(L + TOFF + (c * 65 + r) * 4)); }
    }
}

__device__ __forceinline__ void dn_prep_task(const Params& p, lds_t* L, int task) {
    const int tid = opaque_tid(), lane = tid & 63, w = tid >> 6, fr = lane & 15, lg = lane >> 4;
    const int b = task >> 9, h = (task >> 7) & 3, n = task & 127;
    const bf16_t* PROJ = (const bf16_t*)(p.ws + W_PROJ);
    const float* AB = (const float*)(p.ws + W_AB);
    unsigned char* tb = p.ws + W_DNT + (size_t)task * TASK_BYTES;
    constexpr int RS = 129;
    constexpr int QF = 0, QB = 64 * RS * 4, KB = QB + 64 * 272, KF = KB + 64 * 272, VF = KF + 64 * RS * 4, LM = VF + 64 * RS * 4, SM = LM + 16384, XS = 0;
    __syncthreads();
    const float* wc = p.in[9];
#pragma unroll 2
    for (int k0 = 0; k0 < 6; k0 += 3) {
        u32x4 xr[3][4];
#pragma unroll
        for (int k = 0; k < 3; ++k) { const int idx = tid + NTHR * (k0 + k), i = idx / 48, ck = idx % 48, part = ck >> 4, d0 = (ck & 15) * 8;
            const int ch = part * 512 + h * 128 + d0, t = n * 64 + i;
#pragma unroll
            for (int j = 0; j < 4; ++j) { const int tt = t - 3 + j; xr[k][j] = (tt >= 0) ? *(const u32x4*)(PROJ + (size_t)(b * T_SEQ + tt) * NPROJ + C_DN + ch) : (u32x4){0u, 0u, 0u, 0u}; } }
#pragma unroll
        for (int k = 0; k < 3; ++k) { const int idx = tid + NTHR * (k0 + k), i = idx / 48, ck = idx % 48, part = ck >> 4, d0 = (ck & 15) * 8;
            const int ch = part * 512 + h * 128 + d0;
            float acc[8];
#pragma unroll
            for (int e = 0; e < 8; ++e) acc[e] = 0.f;
#pragma unroll
            for (int j = 0; j < 4; ++j) { const f32x4 w0 = *(const f32x4*)(wc + j * 1536 + ch), w1 = *(const f32x4*)(wc + j * 1536 + ch + 4);
                const f32x4 x0 = bf4_to_f4((u32x2){xr[k][j].x, xr[k][j].y}), x1 = bf4_to_f4((u32x2){xr[k][j].z, xr[k][j].w});
#pragma unroll
                for (int e = 0; e < 4; ++e) { acc[e] += w0[e] * x0[e]; acc[4 + e] += w1[e] * x1[e]; } }
            const int base = (part == 0 ? QF : (part == 1 ? KF : VF)) + (i * RS + d0) * 4;
#pragma unroll
            for (int e = 0; e < 8; ++e) *(LAS float*)(L + base + e * 4) = siluf_(acc[e]);
        }
    }
    if (w == 0) {
        const size_t row = (size_t)b * T_SEQ + n * 64 + lane;
        const float braw = AB[row * 8 + h], araw = AB[row * 8 + 4 + h];
        const float beta = sigmoidf_(braw);
        float g = -__expf(p.in[10][h]) * softplusf_(araw + p.in[11][h]);
#pragma unroll
        for (int o = 1; o < 64; o <<= 1) { const float t2 = __shfl_up(g, o, 64); if (lane >= o) g += t2; }
        *(LAS float*)(L + SM + lane * 4) = g; *(LAS float*)(L + SM + 256 + lane * 4) = beta; *(LAS float*)(L + SM + 512 + lane * 4) = __expf(g);
    }
    __syncthreads();
    for (int ii = 0; ii < 8; ++ii) {
        const int i = w * 8 + ii;
        { float v0 = *(LAS float*)(L + QF + (i * RS + lane) * 4), v1 = *(LAS float*)(L + QF + (i * RS + lane + 64) * 4);
          const float rn = rsqrtf(wave_sum(v0 * v0 + v1 * v1) + 1e-6f) * 0.08838834764831845f; v0 *= rn; v1 *= rn;
          *(LAS float*)(L + QF + (i * RS + lane) * 4) = v0; *(LAS float*)(L + QF + (i * RS + lane + 64) * 4) = v1;
          *(LAS bf16_t*)(L + QB + i * 272 + lane * 2) = f2bf(v0); *(LAS bf16_t*)(L + QB + i * 272 + (lane + 64) * 2) = f2bf(v1); }
        { float v0 = *(LAS float*)(L + KF + (i * RS + lane) * 4), v1 = *(LAS float*)(L + KF + (i * RS + lane + 64) * 4);
          const float rn = rsqrtf(wave_sum(v0 * v0 + v1 * v1) + 1e-6f); v0 *= rn; v1 *= rn;
          *(LAS float*)(L + KF + (i * RS + lane) * 4) = v0; *(LAS float*)(L + KF + (i * RS + lane + 64) * 4) = v1;
          *(LAS bf16_t*)(L + KB + i * 272 + lane * 2) = f2bf(v0); *(LAS bf16_t*)(L + KB + i * 272 + (lane + 64) * 2) = f2bf(v1); }
    }
    __syncthreads();
    for (int jj = 0; jj < 4; ++jj) {
        const int job = w * 4 + jj, which = job >> 4, mi = (job >> 2) & 3, nj = job & 3;
        if (which == 0 && nj > mi) continue;
        f32x4 acc = (f32x4){0.f, 0.f, 0.f, 0.f};
        if (nj <= mi) {
#pragma unroll
            for (int ks = 0; ks < 4; ++ks) {
                const bf16x8 a = *(const LAS bf16x8*)(L + (which ? QB : KB) + (mi * 16 + fr) * 272 + (ks * 32 + lg * 8) * 2);
                const bf16x8 bb = *(const LAS bf16x8*)(L + KB + (nj * 16 + fr) * 272 + (ks * 32 + lg * 8) * 2);
                acc = mfma16(a, bb, acc);
            }
        }
        const int j = nj * 16 + fr; const float gj = *(LAS float*)(L + SM + j * 4);
#pragma unroll
        for (int r = 0; r < 4; ++r) {
            const int i = mi * 16 + lg * 4 + r; const float gi = *(LAS float*)(L + SM + i * 4);
            if (which == 0) { const float v = (j < i) ? *(LAS float*)(L + SM + 256 + i * 4) * acc[r] * __expf(gi - gj) : 0.f; *(LAS float*)(L + LM + (i * 64 + j) * 4) = v; }
            else { const float v = (j <= i) ? acc[r] * __expf(gi - gj) : 0.f; *(bf16_t*)(tb + 81920 + (i * 64 + j) * 2) = f2bf(v); }
        }
    }
    __syncthreads();
    {
        const float glast = *(LAS float*)(L + SM + 63 * 4);
        for (int idx = tid; idx < 8192; idx += NTHR) { const int i = idx >> 7, d = idx & 127;
            *(bf16_t*)(tb + 49152 + idx * 2) = f2bf(*(LAS float*)(L + QF + (i * RS + d) * 4) * *(LAS float*)(L + SM + 512 + i * 4)); }
        for (int idx = tid; idx < 8192; idx += NTHR) { const int d = idx >> 6, i = idx & 63;
            *(bf16_t*)(tb + 65536 + idx * 2) = f2bf(*(LAS float*)(L + KF + (i * RS + d) * 4) * __expf(glast - *(LAS float*)(L + SM + i * 4))); }
        if (tid == 0) { ((float*)(p.ws + W_GL))[task] = __expf(glast); *(float*)(tb + 90112) = __expf(glast); }
    }
    __syncthreads();
    if (tid < 256) {
        const int c = tid;
        for (int blk = 0; blk < 4; ++blk) {
            float r[16];
#pragma unroll
            for (int ii = 0; ii < 16; ++ii) { const int i = blk * 16 + ii; const float beta = *(LAS float*)(L + SM + 256 + i * 4);
                r[ii] = (c < 128) ? beta * *(LAS float*)(L + VF + (i * RS + c) * 4) : beta * *(LAS float*)(L + KF + (i * RS + (c - 128)) * 4) * *(LAS float*)(L + SM + 512 + i * 4); }
            for (int pb = 0; pb < blk; ++pb) {
                float xp[16];
#pragma unroll
                for (int jj = 0; jj < 16; ++jj) xp[jj] = *(LAS float*)(L + XS + ((pb * 16 + jj) * 256 + c) * 4);
#pragma unroll
                for (int ii = 0; ii < 16; ++ii) {
#pragma unroll
                    for (int j4 = 0; j4 < 4; ++j4) { const f32x4 l4 = *(const LAS f32x4*)(L + LM + ((blk * 16 + ii) * 64 + pb * 16 + j4 * 4) * 4);
                        r[ii] -= l4[0] * xp[j4 * 4] + l4[1] * xp[j4 * 4 + 1] + l4[2] * xp[j4 * 4 + 2] + l4[3] * xp[j4 * 4 + 3]; }
                }
            }
#pragma unroll
            for (int ii = 1; ii < 16; ++ii) {
#pragma unroll
                for (int jj = 0; jj < ii; ++jj) r[ii] -= *(LAS float*)(L + LM + ((blk * 16 + ii) * 64 + blk * 16 + jj) * 4) * r[jj];
            }
#pragma unroll
            for (int ii = 0; ii < 16; ++ii) *(LAS float*)(L + XS + ((blk * 16 + ii) * 256 + c) * 4) = r[ii];
            if (c < 128) {
                const int wv = c >> 4;
#pragma unroll
                for (int ii = 0; ii < 16; ++ii) { const int gq = ii >> 2, jr = ii & 3, l = gq * 16 + (c & 15);
                    *(float*)(tb + (size_t)(((wv * 4 + blk) * 64 + l) * 4 + jr) * 4) = r[ii]; }
            } else {
#pragma unroll
                for (int ii = 0; ii < 16; ++ii) *(bf16_t*)(tb + 32768 + ((blk * 16 + ii) * 128 + (c - 128)) * 2) = f2bf(r[ii]);
            }
        }
    }
}

#define SBAR() do { asm volatile("s_waitcnt lgkmcnt(0)" ::: "memory"); __builtin_amdgcn_s_barrier(); asm volatile("" ::: "memory"); } while (0)
__device__ __forceinline__ void dn_scan(const Params& p, lds_t* L, int sb) {
    const int tid = opaque_tid(), lane = tid & 63, w = __builtin_amdgcn_readfirstlane(tid >> 6);
    const int bh = sb >> 3, sl = sb & 7;
    constexpr int BUFSZ = 67584, WKO = 0, QDO = 16384, KDO = 32768, ATO = 49152, U0O = 57344, GLO = 65536, PRIV = 2 * BUFSZ;
    const unsigned char* tb0 = p.ws + W_DNT + (size_t)(bh * 128) * TASK_BYTES;
    if (w >= 2) {
        const int t = tid - 128;
        int soff[11], ldst[11];
#pragma unroll
        for (int i = 0; i < 11; ++i) { int cid = t + 384 * i; if (cid >= 3840) cid = t;
            if (cid < 2048) { const int row = (cid & 1023) >> 4, ch = cid & 15; ldst[i] = (cid >> 10) * 16384 + row * 256 + ((ch ^ (row & 15)) << 4); soff[i] = 32768 + cid * 16; }
            else if (cid < 3584) { const int cl = cid - 2048, row = cl >> 3, ch = cl & 7; ldst[i] = 32768 + row * 128 + ((ch ^ (row & 7)) << 4); soff[i] = 32768 + cid * 16; }
            else { ldst[i] = U0O + (cid - 3584) * 16; soff[i] = sl * 4096 + (cid - 3584) * 16; } }
        if (t == 383) { ldst[10] = GLO; soff[10] = 90112; }
        u32x4 R0[11], R1[11], R2[11];
#define SC_LOAD(R, step) do { const unsigned char* _g = tb0 + (size_t)(step) * TASK_BYTES; \
        _Pragma("unroll") for (int i = 0; i < 11; ++i) R[i] = *(const u32x4*)(_g + soff[i]); } while (0)
#define SC_PUT(R, step) do { lds_t* _d = L + ((step) & 1) * BUFSZ; \
        _Pragma("unroll") for (int i = 0; i < 11; ++i) *(LAS u32x4*)(_d + ldst[i]) = R[i]; } while (0)
        SC_LOAD(R0, 0); SC_LOAD(R1, 1); SC_LOAD(R2, 2);
        SC_PUT(R0, 0); SC_LOAD(R0, 3);
        for (int n0 = 0; n0 < 123; n0 += 3) {
            SBAR(); SC_PUT(R1, n0 + 1); SC_LOAD(R1, n0 + 4); SBAR();
            SBAR(); SC_PUT(R2, n0 + 2); SC_LOAD(R2, n0 + 5); SBAR();
            SBAR(); SC_PUT(R0, n0 + 3); SC_LOAD(R0, n0 + 6); SBAR();
        }
        SBAR(); SC_PUT(R1, 124); SC_LOAD(R1, 127); SBAR();
        SBAR(); SC_PUT(R2, 125); SBAR();
        SBAR(); SC_PUT(R0, 126); SBAR();
        SBAR(); SC_PUT(R1, 127); SBAR();
        SBAR(); SBAR();
#undef SC_LOAD
#undef SC_PUT
    } else {
        const int fr = lane & 15, lg = lane >> 4;
        lds_t* ST = L + PRIV; lds_t* UT = ST + 4096;
        f32x4 S[4];
#pragma unroll
        for (int m = 0; m < 4; ++m) S[m] = (f32x4){0.f, 0.f, 0.f, 0.f};
        for (int n = 0; n < 128; ++n) {
#pragma unroll
            for (int m = 0; m < 4; ++m) { const int mm = 4 * w + m; u32x2 v; v[0] = pk2(S[m][0], S[m][1]); v[1] = pk2(S[m][2], S[m][3]);
                *(LAS u32x2*)(ST + fr * 256 + (((mm * 2 + (lg >> 1)) ^ fr) << 4) + (lg & 1) * 8) = v; }
            SBAR();
            bf16x8 sb4[4];
#pragma unroll
            for (int ks = 0; ks < 4; ++ks) sb4[ks] = *(const LAS bf16x8*)(ST + fr * 256 + (((ks * 4 + lg) ^ fr) << 4));
            lds_t* B = L + (n & 1) * BUFSZ;
            const float glc = *(const LAS float*)(B + GLO);
            f32x4 au[2], ao[2];
#pragma unroll
            for (int q = 0; q < 2; ++q) { const int mt = 2 * w + q; au[q] = (f32x4){0.f, 0.f, 0.f, 0.f}; ao[q] = (f32x4){0.f, 0.f, 0.f, 0.f};
#pragma unroll
                for (int ks = 0; ks < 4; ++ks) {
                    const int rofs = (mt * 16 + fr) * 256 + (((ks * 4 + lg) ^ fr) << 4);
                    const bf16x8 a1 = *(const LAS bf16x8*)(B + WKO + rofs); const bf16x8 a2 = *(const LAS bf16x8*)(B + QDO + rofs);
                    au[q] = mfma16(a1, sb4[ks], au[q]); ao[q] = mfma16(a2, sb4[ks], ao[q]);
                }
            }
#pragma unroll
            for (int q = 0; q < 2; ++q) { const int mt = 2 * w + q; const f32x4 u0 = *(const LAS f32x4*)(B + U0O + (mt * 64 + lane) * 16);
                f32x4 u = u0 - au[q]; u32x2 v; v[0] = pk2(u[0], u[1]); v[1] = pk2(u[2], u[3]);
                *(LAS u32x2*)(UT + fr * 128 + (((mt * 2 + (lg >> 1)) ^ (fr & 7)) << 4) + (lg & 1) * 8) = v; }
            SBAR();
            bf16x8 ub[2];
#pragma unroll
            for (int ks = 0; ks < 2; ++ks) ub[ks] = *(const LAS bf16x8*)(UT + fr * 128 + (((ks * 4 + lg) ^ (fr & 7)) << 4));
#pragma unroll
            for (int q = 0; q < 2; ++q) { const int mt = 2 * w + q;
#pragma unroll
                for (int ks = 0; ks < 2; ++ks) { const bf16x8 a = *(const LAS bf16x8*)(B + ATO + (mt * 16 + fr) * 128 + (((ks * 4 + lg) ^ (fr & 7)) << 4)); ao[q] = mfma16(a, ub[ks], ao[q]); } }
#pragma unroll
            for (int m = 0; m < 4; ++m) { const int mm = 4 * w + m; S[m] = S[m] * glc;
#pragma unroll
                for (int ks = 0; ks < 2; ++ks) { const bf16x8 a = *(const LAS bf16x8*)(B + KDO + (mm * 16 + fr) * 128 + (((ks * 4 + lg) ^ (fr & 7)) << 4)); S[m] = mfma16(a, ub[ks], S[m]); } }
            float* osc = (float*)(p.ws + W_OSC + (size_t)(bh * 128 + n) * 32768);
#pragma unroll
            for (int q = 0; q < 2; ++q) *(f32x4*)(osc + ((sl * 4 + 2 * w + q) * 64 + lane) * 4) = ao[q];
        }
        float* ps = p.out + O_PDS + (size_t)bh * 16384;
#pragma unroll
        for (int m = 0; m < 4; ++m)
#pragma unroll
            for (int r = 0; r < 4; ++r) ps[((4 * w + m) * 16 + lg * 4 + r) * 128 + sl * 16 + fr] = S[m][r];
    }
    __syncthreads();
}

__device__ __forceinline__ void dn_norm_item(const Params& p, int item) {
    const int pm = item >> 2, h = item & 3;
    const int tid = opaque_tid(), lane = tid & 63, w = tid >> 6;
    const bf16_t* PROJ = (const bf16_t*)(p.ws + W_PROJ);
    bf16_t* ODN = (bf16_t*)(p.ws + W_ODN);
    const int e0 = 2 * lane, sl = e0 >> 4, fr = e0 & 15;
    const float wn0 = p.in[12][e0], wn1 = p.in[12][e0 + 1];
    for (int it0 = 0; it0 < 8; it0 += 4) {
        f32x4 va[4], vb[4]; unsigned zz[4][4];
#pragma unroll
        for (int u = 0; u < 4; ++u) {
            const int rq = (it0 + u) * 8 + w;
            const int row0 = pm * 256 + rq * 4, b = row0 >> 13, t = row0 & (T_SEQ - 1), n = t >> 6, i0 = t & 63;
            const float* src = (const float*)(p.ws + W_OSC + (size_t)((b * 4 + h) * 128 + n) * 32768) + ((sl * 4 + (i0 >> 4)) * 64 + ((i0 & 15) >> 2) * 16 + fr) * 4;
            va[u] = *(const f32x4*)src; vb[u] = *(const f32x4*)(src + 4);
#pragma unroll
            for (int r = 0; r < 4; ++r) zz[u][r] = *(const unsigned*)(PROJ + (size_t)(row0 + r) * NPROJ + C_Z + h * 128 + e0);
        }
#pragma unroll
        for (int u = 0; u < 4; ++u) {
            const int rq = (it0 + u) * 8 + w;
            const int row0 = pm * 256 + rq * 4;
#pragma unroll
            for (int r = 0; r < 4; ++r) {
                const float ss = wave_sum(va[u][r] * va[u][r] + vb[u][r] * vb[u][r]); const float rs = rsqrtf(ss * (1.0f / 128.0f) + 1e-6f);
                const float z0 = __uint_as_float(zz[u][r] << 16), z1 = __uint_as_float(zz[u][r] & 0xFFFF0000u);
                *(unsigned*)(ODN + (size_t)(row0 + r) * 512 + h * 128 + e0) = pk2(va[u][r] * rs * wn0 * siluf_(z0), vb[u][r] * rs * wn1 * siluf_(z1));
            }
        }
    }
}

__device__ __forceinline__ void attn_prompt_item(const Params& p, lds_t* L, int item) {
    const int tid = opaque_tid(), lane = tid & 63, w = tid >> 6, fr = lane & 15, lg = lane >> 4;
    const int b = item >> 7, blk = (item >> 2) & 31, h = item & 3;
    const bf16_t* PROJ = (const bf16_t*)(p.ws + W_PROJ);
    float* OG = (float*)(p.ws + W_OG); float* LSE = (float*)(p.ws + W_LSE);
    lds_t* VS = L + w * 4352;
    const int T0 = blk * 256;
    for (int wt = w; wt < 48; wt += 8) {
        const int grp = wt >> 4, qt = wt & 15;
        const int dl = grp == 0 ? 0 : (grp == 1 ? 2 : 4), dil = 1 << dl;
        const int tpr = 16 >> dl;
        const int res = qt / tpr, qq = qt % tpr;
        const int j0 = (T0 >> dl) + qq * 16;
        const float slope_d = exp2f(-8.0f * (float)(grp * 4 + h + 1) / 12.0f) * (float)dil;
        const size_t rowbase = (size_t)b * T_SEQ;
        const int tq = ((j0 + fr) << dl) + res;
        bf16x8 qb[2];
#pragma unroll
        for (int ks = 0; ks < 2; ++ks) qb[ks] = *(const bf16x8*)(PROJ + (rowbase + tq) * NPROJ + grp * 256 + h * 64 + ks * 32 + lg * 8);
        f32x4 o[4];
#pragma unroll
        for (int dt = 0; dt < 4; ++dt) o[dt] = (f32x4){0.f, 0.f, 0.f, 0.f};
        float mrun = -1e30f, lrun = 0.f;
        const int jq = j0 + fr;
        u32x4 vreg[2][4]; bf16x8 kreg[2][2][2];
#define AT_LOAD(kt, bufi) do { const int _jb = j0 - 144 + (kt) * 32; \
            _Pragma("unroll") for (int i = 0; i < 4; ++i) { const int c = lane + 64 * i, key = c >> 3, part = c & 7; int jk = _jb + key; jk = jk < 0 ? 0 : jk; \
                vreg[bufi][i] = *(const u32x4*)(PROJ + (rowbase + (jk << dl) + res) * NPROJ + C_AV + grp * 256 + h * 64 + part * 8); } \
            _Pragma("unroll") for (int kh = 0; kh < 2; ++kh) { int jk = _jb + kh * 16 + fr; jk = jk < 0 ? 0 : jk; \
                const bf16_t* kp = PROJ + (rowbase + (jk << dl) + res) * NPROJ + C_AK + grp * 256 + h * 64 + lg * 8; \
                kreg[bufi][kh][0] = *(const bf16x8*)kp; kreg[bufi][kh][1] = *(const bf16x8*)(kp + 32); } } while (0)
        AT_LOAD(0, 0);
#pragma unroll
        for (int kt = 0; kt < 5; ++kt) {
            const int jb = j0 - 144 + kt * 32, cur = kt & 1;
            if (kt + 1 < 5) AT_LOAD(kt + 1, cur ^ 1);
#pragma unroll
            for (int i = 0; i < 4; ++i) { const int c = lane + 64 * i, key = c >> 3, part = c & 7; const u32x4 v = vreg[cur][i];
                *(LAS u32x2*)(VS + key * 136 + part * 16) = (u32x2){v.x, v.y}; *(LAS u32x2*)(VS + key * 136 + part * 16 + 8) = (u32x2){v.z, v.w}; }
            f32x4 sc[2];
#pragma unroll
            for (int kh = 0; kh < 2; ++kh) { sc[kh] = (f32x4){0.f, 0.f, 0.f, 0.f};
#pragma unroll
                for (int ks = 0; ks < 2; ++ks) sc[kh] = mfma16(kreg[cur][kh][ks], qb[ks], sc[kh]); }
            float mx = -1e30f;
#pragma unroll
            for (int kh = 0; kh < 2; ++kh)
#pragma unroll
                for (int r = 0; r < 4; ++r) { const int jk = jb + kh * 16 + lg * 4 + r; const int dist = jq - jk;
                    const bool ok = (jk >= 0) && (dist >= 0) && (dist <= 128);
                    const float s = ok ? sc[kh][r] * 0.125f - slope_d * (float)dist : -1e30f; sc[kh][r] = s; mx = fmaxf(mx, s); }
            mx = fmaxf(mx, __shfl_xor(mx, 16, 64)); mx = fmaxf(mx, __shfl_xor(mx, 32, 64));
            const float mnew = fmaxf(mrun, mx); const float scale = __expf(mrun - mnew); mrun = mnew;
            float ps = 0.f; float pv[8];
#pragma unroll
            for (int kh = 0; kh < 2; ++kh)
#pragma unroll
                for (int r = 0; r < 4; ++r) { const float s = sc[kh][r]; const float pe = s > -1e29f ? __expf(s - mnew) : 0.f; pv[kh * 4 + r] = pe; ps += pe; }
            lrun = lrun * scale + ps;
            bf16x8 pb; { unsigned* pw = (unsigned*)&pb; pw[0] = pk2(pv[0], pv[1]); pw[1] = pk2(pv[2], pv[3]); pw[2] = pk2(pv[4], pv[5]); pw[3] = pk2(pv[6], pv[7]); }
            WSYNC();
#pragma unroll
            for (int dt = 0; dt < 4; ++dt) {
                bf16x8 va; unsigned short* vs = (unsigned short*)&va;
#pragma unroll
                for (int i = 0; i < 8; ++i) { const int key = (i < 4) ? (lg * 4 + i) : (16 + lg * 4 + (i - 4)); vs[i] = *(const LAS bf16_t*)(VS + key * 136 + (dt * 16 + fr) * 2); }
                o[dt] = o[dt] * scale; o[dt] = mfma16(va, pb, o[dt]);
            }
            WSYNC();
        }
#undef AT_LOAD
        lrun += __shfl_xor(lrun, 16, 64); lrun += __shfl_xor(lrun, 32, 64);
        const float inv = 1.0f / lrun;
        const size_t orow = rowbase + tq;
#pragma unroll
        for (int dt = 0; dt < 4; ++dt) { f32x4 v = o[dt] * inv; *(f32x4*)(OG + ((size_t)grp * NPROMPT + orow) * 256 + h * 64 + dt * 16 + lg * 4) = v; }
        if (lg == 0) LSE[((size_t)grp * NPROMPT + orow) * 4 + h] = mrun + __logf(lrun);
    }
    asm volatile("s_waitcnt vmcnt(0)" ::: "memory");
    __syncthreads();
    {
        bf16_t* OATT = (bf16_t*)(p.ws + W_OATT);
        const int i = tid >> 1, half = tid & 1; const size_t row = (size_t)b * T_SEQ + T0 + i;
        const float l0 = LSE[(0 * (size_t)NPROMPT + row) * 4 + h], l1 = LSE[(1 * (size_t)NPROMPT + row) * 4 + h], l2 = LSE[(2 * (size_t)NPROMPT + row) * 4 + h];
        const float mx = fmaxf(l0, fmaxf(l1, l2)); float w0 = __expf(l0 - mx), w1 = __expf(l1 - mx), w2 = __expf(l2 - mx); const float inv = 1.0f / (w0 + w1 + w2); w0 *= inv; w1 *= inv; w2 *= inv;
#pragma unroll
        for (int c4 = 0; c4 < 8; ++c4) { const int col = h * 64 + half * 32 + c4 * 4;
            const f32x4 a0 = *(const f32x4*)(OG + (0 * (size_t)NPROMPT + row) * 256 + col), a1 = *(const f32x4*)(OG + (1 * (size_t)NPROMPT + row) * 256 + col), a2 = *(const f32x4*)(OG + (2 * (size_t)NPROMPT + row) * 256 + col);
            const f32x4 r = a0 * w0 + a1 * w1 + a2 * w2; u32x2 v; v[0] = pk2(r[0], r[1]); v[1] = pk2(r[2], r[3]);
            *(u32x2*)(OATT + row * 256 + col) = v; }
    }
}

__device__ __forceinline__ void attn_decode_item(const Params& p, lds_t* L, int b) {
    const int tid = opaque_tid(), lane = tid & 63, w = tid >> 6, sub = lane & 15, kq = lane >> 4;
    const bf16_t* PROJ = (const bf16_t*)(p.ws + W_PROJ);
    const size_t prow = (size_t)(NPROMPT + b) * NPROJ;
#pragma unroll 1
    for (int idx = w; idx < 12; idx += 8) {
        const int grp = idx >> 2, h = idx & 3;
        const int dl = grp == 0 ? 0 : (grp == 1 ? 2 : 4), dil = 1 << dl, n = 128 << dl;
        const float* cache = (grp == 0 ? p.in[2] : (grp == 1 ? p.in[3] : p.in[4])) + (size_t)b * n * 512;
        const float slope_d = exp2f(-8.0f * (float)(grp * 4 + h + 1) / 12.0f) * (float)dil;
        f32x4 q4 = bf4_to_f4(*(const u32x2*)(PROJ + prow + grp * 256 + h * 64 + sub * 4));
        lds_t* SC = L + w * 544;
#pragma unroll 1
        for (int it0 = 0; it0 < 32; it0 += 8) {
            f32x4 k4[8];
#pragma unroll
            for (int u = 0; u < 8; ++u) k4[u] = *(const f32x4*)(cache + (size_t)(((it0 + u) * 4 + kq) * dil) * 512 + h * 64 + sub * 4);
#pragma unroll
            for (int u = 0; u < 8; ++u) { const int c = (it0 + u) * 4 + kq;
                const float part = sum16(q4[0] * k4[u][0] + q4[1] * k4[u][1] + q4[2] * k4[u][2] + q4[3] * k4[u][3]);
                if (sub == 0) *(LAS float*)(SC + c * 4) = part * 0.125f - slope_d * (float)(128 - c); }
        }
        {
            const f32x4 kn = bf4_to_f4(*(const u32x2*)(PROJ + prow + C_AK + grp * 256 + h * 64 + sub * 4));
            const float part = sum16(q4[0] * kn[0] + q4[1] * kn[1] + q4[2] * kn[2] + q4[3] * kn[3]);
            if (sub == 0) *(LAS float*)(SC + (128 + kq) * 4) = (kq == 0) ? part * 0.125f : -1e30f;
        }
        WSYNC();
        const float s0 = *(LAS float*)(SC + lane * 4), s1 = *(LAS float*)(SC + (lane + 64) * 4), s2 = lane < 4 ? *(LAS float*)(SC + (lane + 128) * 4) : -1e30f;
        const float m = wave_max(fmaxf(s0, fmaxf(s1, s2)));
        const float p0 = __expf(s0 - m), p1 = __expf(s1 - m), p2 = lane < 4 ? __expf(s2 - m) : 0.f;
        const float lsum = wave_sum(p0 + p1 + p2);
        WSYNC();
        *(LAS float*)(SC + lane * 4) = p0; *(LAS float*)(SC + (lane + 64) * 4) = p1; if (lane < 4) *(LAS float*)(SC + (lane + 128) * 4) = p2;
        WSYNC();
        f32x4 acc = (f32x4){0.f, 0.f, 0.f, 0.f};
#pragma unroll 1
        for (int it0 = 0; it0 < 32; it0 += 8) {
            f32x4 v4[8];
#pragma unroll
            for (int u = 0; u < 8; ++u) v4[u] = *(const f32x4*)(cache + (size_t)(((it0 + u) * 4 + kq) * dil) * 512 + 256 + h * 64 + sub * 4);
#pragma unroll
            for (int u = 0; u < 8; ++u) { const float pc = *(LAS float*)(SC + ((it0 + u) * 4 + kq) * 4); acc += v4[u] * pc; }
        }
        if (kq == 0) { const float pc = *(LAS float*)(SC + 128 * 4); acc += bf4_to_f4(*(const u32x2*)(PROJ + prow + C_AV + grp * 256 + h * 64 + sub * 4)) * pc; }
#pragma unroll
        for (int j = 0; j < 4; ++j) { acc[j] += __shfl_xor(acc[j], 16, 64); acc[j] += __shfl_xor(acc[j], 32, 64); }
        const float inv = 1.0f / lsum;
        if (kq == 0) {
#pragma unroll
            for (int j = 0; j < 4; ++j) *(LAS float*)(L + 8192 + (idx * 65 + sub * 4 + j) * 4) = acc[j] * inv;
        }
        if (lane == 0) *(LAS float*)(L + 8192 + 3120 + idx * 4) = m + __logf(lsum);
        WSYNC();
    }
    __syncthreads();
    if (tid < 256) {
        const int h = tid >> 6, d = tid & 63;
        const float l0 = *(LAS float*)(L + 8192 + 3120 + h * 4), l1 = *(LAS float*)(L + 8192 + 3120 + (4 + h) * 4), l2 = *(LAS float*)(L + 8192 + 3120 + (8 + h) * 4);
        const float mx = fmaxf(l0, fmaxf(l1, l2)); const float w0 = __expf(l0 - mx), w1 = __expf(l1 - mx), w2 = __expf(l2 - mx);
        const float r = (w0 * *(LAS float*)(L + 8192 + (h * 65 + d) * 4) + w1 * *(LAS float*)(L + 8192 + ((4 + h) * 65 + d) * 4) + w2 * *(LAS float*)(L + 8192 + ((8 + h) * 65 + d) * 4)) / (w0 + w1 + w2);
        ((bf16_t*)(p.ws + W_OATT))[(size_t)(NPROMPT + b) * 256 + h * 64 + d] = f2bf(r);
    }
}

__device__ __forceinline__ void dn_rec_item(const Params& p, lds_t* L, int item) {
    const int tid = opaque_tid(), b = item >> 2, h = item & 3;
    const bf16_t* PROJ = (const bf16_t*)(p.ws + W_PROJ);
    const float* AB = (const float*)(p.ws + W_AB);
    const size_t prow = (size_t)(NPROMPT + b) * NPROJ;
    const float* cst = p.in[5] + (size_t)b * 3 * 1536;
    if (tid < 384) {
        const int part = tid >> 7, d = tid & 127, ch = part * 512 + h * 128 + d;
        const float* wc = p.in[9];
        const float xn = bf2f(PROJ[prow + C_DN + ch]);
        const float x0 = cst[ch], x1 = cst[1536 + ch], x2 = cst[3072 + ch];
        const float v = wc[ch] * x0 + wc[1536 + ch] * x1 + wc[3072 + ch] * x2 + wc[4608 + ch] * xn;
        *(LAS float*)(L + tid * 4) = siluf_(v);
        float* sdc = p.out + O_SDC + (size_t)b * 3 * 1536;
        sdc[ch] = x1; sdc[1536 + ch] = x2; sdc[3072 + ch] = xn;
    }
    __syncthreads();
    {
        const int w = tid >> 6, lane = tid & 63;
        if (w < 3) {
            const float q0 = *(LAS float*)(L + lane * 4), q1 = *(LAS float*)(L + (lane + 64) * 4), k0 = *(LAS float*)(L + (128 + lane) * 4), k1 = *(LAS float*)(L + (192 + lane) * 4);
            float v = w == 0 ? q0 * q0 + q1 * q1 : (w == 1 ? k0 * k0 + k1 * k1 : q0 * k0 + q1 * k1);
            v = wave_sum(v); if (lane == 0) *(LAS float*)(L + 1536 + w * 4) = v;
        }
    }
    __syncthreads();
    const float rq = rsqrtf(*(LAS float*)(L + 1536) + 1e-6f) * 0.08838834764831845f, rk = rsqrtf(*(LAS float*)(L + 1540) + 1e-6f);
    const float qk = *(LAS float*)(L + 1544) * rq * rk;
    const float beta = sigmoidf_(AB[(size_t)(NPROMPT + b) * 8 + h]);
    const float eg = __expf(-__expf(p.in[10][h]) * softplusf_(AB[(size_t)(NPROMPT + b) * 8 + 4 + h] + p.in[11][h]));
    const float* S0 = p.in[6] + (size_t)item * 16384;
    const int e4 = (tid & 31) * 4, dg = tid >> 5;
    f32x4 s[8]; f32x4 ks = (f32x4){0.f, 0.f, 0.f, 0.f}, qs = (f32x4){0.f, 0.f, 0.f, 0.f};
#pragma unroll
    for (int r = 0; r < 8; ++r) { const int d = dg * 8 + r; s[r] = *(const f32x4*)(S0 + d * 128 + e4);
        const float kd = *(LAS float*)(L + (128 + d) * 4) * rk, qd = *(LAS float*)(L + d * 4) * rq; ks += s[r] * kd; qs += s[r] * qd; }
    *(LAS f32x4*)(L + 2048 + (dg * 128 + e4) * 4) = ks; *(LAS f32x4*)(L + 10240 + (dg * 128 + e4) * 4) = qs;
    __syncthreads();
    if (tid < 128) {
        float kS = 0.f, qS = 0.f;
#pragma unroll
        for (int g = 0; g < 16; ++g) { kS += *(LAS float*)(L + 2048 + (g * 128 + tid) * 4); qS += *(LAS float*)(L + 10240 + (g * 128 + tid) * 4); }
        const float v = *(LAS float*)(L + (256 + tid) * 4);
        const float u = beta * (v - eg * kS);
        const float o = eg * qS + qk * u;
        *(LAS float*)(L + 18432 + tid * 4) = u; *(LAS float*)(L + 18944 + tid * 4) = o;
    }
    __syncthreads();
    {
        const f32x4 u4 = *(const LAS f32x4*)(L + 18432 + e4 * 4);
        float* So = p.out + O_SDS + (size_t)item * 16384;
#pragma unroll
        for (int r = 0; r < 8; ++r) { const int d = dg * 8 + r; const float kd = *(LAS float*)(L + (128 + d) * 4) * rk; *(f32x4*)(So + d * 128 + e4) = s[r] * eg + u4 * kd; }
    }
    if (tid < 64) {
        const float o0 = *(LAS float*)(L + 18944 + tid * 4), o1 = *(LAS float*)(L + 18944 + (tid + 64) * 4);
        const float ms = wave_sum(o0 * o0 + o1 * o1) * (1.0f / 128.0f); const float rs = rsqrtf(ms + 1e-6f);
        bf16_t* ODN = (bf16_t*)(p.ws + W_ODN);
        const float z0 = bf2f(PROJ[prow + C_Z + h * 128 + tid]), z1 = bf2f(PROJ[prow + C_Z + h * 128 + tid + 64]);
        ODN[(size_t)(NPROMPT + b) * 512 + h * 128 + tid] = f2bf(o0 * rs * p.in[12][tid] * siluf_(z0));
        ODN[(size_t)(NPROMPT + b) * 512 + h * 128 + tid + 64] = f2bf(o1 * rs * p.in[12][tid + 64] * siluf_(z1));
    }
}

constexpr int NCHUNK = 2688;
__device__ __forceinline__ void kv_copy_chunk(const Params& p, int cidx) {
    const int tid = opaque_tid();
    int grp, cl;
    if (cidx < 128) { grp = 0; cl = cidx; } else if (cidx < 640) { grp = 1; cl = cidx - 128; } else { grp = 2; cl = cidx - 640; }
    const int dl = grp * 2;
    const f32x4* src = (const f32x4*)(grp == 0 ? p.in[2] : (grp == 1 ? p.in[3] : p.in[4])) + (size_t)cl * 16384;
    f32x4* dst = (f32x4*)(p.out + (grp == 0 ? O_SKV0 : (grp == 1 ? O_SKV1 : O_SKV2))) + (size_t)cl * 16384;
    const int pmask = (1 << (14 + dl)) - 1, q0 = (cl * 16384) & pmask;
    f32x4 va[8], vb[8];
#define CP_LOAD(v, k) do { _Pragma("unroll") for (int u = 0; u < 8; ++u) { const int o = ((k) * 8 + u) * NTHR + tid; \
        const bool ok = ((q0 + o) & pmask) < pmask + 1 - 128; v[u] = __builtin_nontemporal_load(src + o + (ok ? 128 : 0)); } } while (0)
#define CP_STORE(v, k) do { _Pragma("unroll") for (int u = 0; u < 8; ++u) { const int o = ((k) * 8 + u) * NTHR + tid; \
        if (((q0 + o) & pmask) < pmask + 1 - 128) __builtin_nontemporal_store(v[u], dst + o); } } while (0)
    CP_LOAD(va, 0); CP_LOAD(vb, 1); CP_STORE(va, 0); CP_LOAD(va, 2); CP_STORE(vb, 1); CP_LOAD(vb, 3); CP_STORE(va, 2); CP_STORE(vb, 3);
#undef CP_LOAD
#undef CP_STORE
}
__device__ __forceinline__ void kv_lastrow_item(const Params& p, int part) {
    const bf16_t* PROJ = (const bf16_t*)(p.ws + W_PROJ);
    const int tid = opaque_tid();
    u32x2 v[4];
#pragma unroll
    for (int u = 0; u < 4; ++u) { const int i = part * 2048 + u * NTHR + tid;
        const int grp = i >> 14, b = (i >> 7) & 127, e = i & 127, s = e >> 6, rem = (e & 63) * 4;
        v[u] = *(const u32x2*)(PROJ + (size_t)(NPROMPT + b) * NPROJ + C_AK + s * 768 + grp * 256 + rem); }
#pragma unroll
    for (int u = 0; u < 4; ++u) { const int i = part * 2048 + u * NTHR + tid;
        const int grp = i >> 14, b = (i >> 7) & 127, e = i & 127, n = 128 << (grp * 2);
        f32x4* dst = (f32x4*)(p.out + (grp == 0 ? O_SKV0 : (grp == 1 ? O_SKV1 : O_SKV2)));
        dst[((size_t)b * n + (n - 1)) * 128 + e] = bf4_to_f4(v[u]); }
}
__device__ __forceinline__ void pkv_chunk(const Params& p, int cidx) {
    const int tid = opaque_tid();
    const bf16_t* PROJ = (const bf16_t*)(p.ws + W_PROJ);
    for (int i0 = 0; i0 < 32; i0 += 8) {
        u32x2 v[8];
#pragma unroll
        for (int u = 0; u < 8; ++u) { const int q = cidx * 16384 + (i0 + u) * NTHR + tid;
            int grp, ql; if (q < 32768) { grp = 0; ql = q; } else if (q < 163840) { grp = 1; ql = q - 32768; } else { grp = 2; ql = q - 163840; }
            const int keep = 128 << (grp * 2);
            const int b = ql / (keep * 128), r = (ql / 128) % keep, e = ql & 127, s = e >> 6, rem = (e & 63) * 4;
            v[u] = *(const u32x2*)(PROJ + ((size_t)b * T_SEQ + T_SEQ - keep + r) * NPROJ + C_AK + s * 768 + grp * 256 + rem); }
#pragma unroll
        for (int u = 0; u < 8; ++u) { const int q = cidx * 16384 + (i0 + u) * NTHR + tid;
            int grp, ql; if (q < 32768) { grp = 0; ql = q; } else if (q < 163840) { grp = 1; ql = q - 32768; } else { grp = 2; ql = q - 163840; }
            float* dst = p.out + (grp == 0 ? O_PKV0 : (grp == 1 ? O_PKV1 : O_PKV2));
            *(f32x4*)(dst + (size_t)ql * 4) = bf4_to_f4(v[u]); }
    }
}
__device__ __forceinline__ void pdc_item(const Params& p) {
    const bf16_t* PROJ = (const bf16_t*)(p.ws + W_PROJ);
    for (int i = opaque_tid(); i < 9216; i += NTHR) { const int b = i / 4608, j = (i / 1536) % 3, c = i % 1536;
        p.out[O_PDC + i] = bf2f(PROJ[((size_t)b * T_SEQ + T_SEQ - 3 + j) * NPROJ + C_DN + c]); }
}

template <bool FINAL>
__device__ __forceinline__ void phase_ln(const Params& p, const float* gam, const float* bet) {
    const int tid = opaque_tid(), lane = tid & 63, w = tid >> 6;
    const float* PRE = (const float*)(p.ws + W_PRE);
    float* H = (float*)(p.ws + W_H); bf16_t* HB = (bf16_t*)(p.ws + W_HB);
    f32x4 g4[4], b4[4];
#pragma unroll
    for (int i = 0; i < 4; ++i) { g4[i] = *(const f32x4*)(gam + 4 * (lane + 64 * i)); b4[i] = *(const f32x4*)(bet + 4 * (lane + 64 * i)); }
    for (int r = blockIdx.x * 8 + w; r < MROWS; r += gridDim.x * 8) {
        f32x4 x[4]; float s = 0.f;
#pragma unroll
        for (int i = 0; i < 4; ++i) { x[i] = *(const f32x4*)(PRE + (size_t)r * DM + 4 * (lane + 64 * i)); s += x[i][0] + x[i][1] + x[i][2] + x[i][3]; }
        const float mu = wave_sum(s) * (1.0f / 1024.0f); float v = 0.f;
#pragma unroll
        for (int i = 0; i < 4; ++i) { x[i] = x[i] - mu; v += x[i][0] * x[i][0] + x[i][1] * x[i][1] + x[i][2] * x[i][2] + x[i][3] * x[i][3]; }
        const float rs = rsqrtf(wave_sum(v) * (1.0f / 1024.0f) + 1e-5f);
#pragma unroll
        for (int i = 0; i < 4; ++i) { const f32x4 y = x[i] * rs * g4[i] + b4[i]; const int c = 4 * (lane + 64 * i);
            if (FINAL) { float* dst = r < NPROMPT ? p.out + O_Y + (size_t)r * DM : p.out + O_YS + (size_t)(r - NPROMPT) * DM; *(f32x4*)(dst + c) = y; }
            else { *(f32x4*)(H + (size_t)r * DM + c) = y; u32x2 o; o[0] = pk2(y[0], y[1]); o[1] = pk2(y[2], y[3]); *(u32x2*)(HB + (size_t)r * DM + c) = o;
                   if (r >= NPROMPT) *(f32x4*)((float*)(p.ws + W_PRE) + (size_t)r * DM + c) = y * ALPHA; } }
    }
}

__device__ __forceinline__ void unpack8(const u32x4 q, float* o) {
    const f32x4 t0 = bf4_to_f4((u32x2){q.x, q.y}), t1 = bf4_to_f4((u32x2){q.z, q.w});
#pragma unroll
    for (int j = 0; j < 4; ++j) { o[j] = t0[j]; o[4 + j] = t1[j]; }
}
__device__ __forceinline__ void phase_ffn_act(const Params& p) {
    const bf16_t* UP = (const bf16_t*)(p.ws + W_UP); bf16_t* ACT = (bf16_t*)(p.ws + W_ACT);
    const float* wc = p.in[19]; const float* bc = p.in[20];
    const int gtid = blockIdx.x * NTHR + opaque_tid(), gn = gridDim.x * NTHR;
    for (int idx = gtid; idx < 2048 * 352; idx += gn) {
        const int seg = idx / 352, c0 = (idx % 352) * 8, row0 = seg * 8, t0 = row0 & (T_SEQ - 1);
        float w0[8], w1[8], w2[8], bb[8];
#pragma unroll
        for (int j = 0; j < 8; ++j) { w0[j] = wc[c0 + j]; w1[j] = wc[DFF + c0 + j]; w2[j] = wc[2 * DFF + c0 + j]; bb[j] = bc[c0 + j]; }
        u32x4 ar[10], gr[8];
#pragma unroll
        for (int r = 0; r < 10; ++r) { const int t = t0 - 2 + r; ar[r] = (t >= 0) ? *(const u32x4*)(UP + (size_t)(row0 - 2 + r) * NUP + c0) : (u32x4){0u, 0u, 0u, 0u}; }
#pragma unroll
        for (int r = 0; r < 8; ++r) gr[r] = *(const u32x4*)(UP + (size_t)(row0 + r) * NUP + DFF + c0);
        float am2[8], am1[8], a0[8], gv[8];
        unpack8(ar[0], am2); unpack8(ar[1], am1);
#pragma unroll
        for (int r = 0; r < 8; ++r) {
            unpack8(ar[r + 2], a0); unpack8(gr[r], gv);
            unsigned o[4];
#pragma unroll
            for (int j = 0; j < 8; j += 2) {
                const float v0 = gelu_tanh(w0[j] * am2[j] + w1[j] * am1[j] + w2[j] * a0[j] + bb[j]) * gv[j];
                const float v1 = gelu_tanh(w0[j + 1] * am2[j + 1] + w1[j + 1] * am1[j + 1] + w2[j + 1] * a0[j + 1] + bb[j + 1]) * gv[j + 1];
                o[j >> 1] = pk2(v0, v1);
            }
            *(u32x4*)(ACT + (size_t)(row0 + r) * DFF + c0) = (u32x4){o[0], o[1], o[2], o[3]};
            if (t0 + r >= T_SEQ - 2) { float* d = p.out + O_PFC + ((size_t)(row0 >> 13) * 2 + (t0 + r - (T_SEQ - 2))) * DFF + c0;
#pragma unroll
                for (int j = 0; j < 8; ++j) d[j] = a0[j]; }
#pragma unroll
            for (int j = 0; j < 8; ++j) { am2[j] = am1[j]; am1[j] = a0[j]; }
        }
    }
    for (int idx = gtid; idx < NSAMP * 352; idx += gn) {
        const int b = idx / 352, c0 = (idx % 352) * 8; const size_t row = (size_t)NPROMPT + b;
        float a0[8], gv[8];
        unpack8(*(const u32x4*)(UP + row * NUP + c0), a0); unpack8(*(const u32x4*)(UP + row * NUP + DFF + c0), gv);
        const float* st = p.in[7] + (size_t)b * 2 * DFF + c0; float* d = p.out + O_SFC + (size_t)b * 2 * DFF + c0;
        unsigned o[4];
#pragma unroll
        for (int j = 0; j < 8; j += 2) {
            float r2[2];
#pragma unroll
            for (int q = 0; q < 2; ++q) { const int jj = j + q; const float am2 = st[jj], am1 = st[DFF + jj]; d[jj] = am1; d[DFF + jj] = a0[jj];
                r2[q] = gelu_tanh(wc[c0 + jj] * am2 + wc[DFF + c0 + jj] * am1 + wc[2 * DFF + c0 + jj] * a0[jj] + bc[c0 + jj]) * gv[jj]; }
            o[j >> 1] = pk2(r2[0], r2[1]);
        }
        *(u32x4*)(ACT + row * DFF + c0) = (u32x4){o[0], o[1], o[2], o[3]};
    }
}

constexpr int CH_P2_END = 0;
constexpr int IT_PDC = 0, IT_LAST = 1, IT_PKV = 25, IT_DEC = 67, IT_ATT = 195, IT_REC = 451, IT_END = 963;
constexpr int NSCAN = 64;
constexpr int CW_Q3 = 0, CW_Q2 = 16, CW_CHUNK = 32, CW_DONE = 48;
__device__ __forceinline__ unsigned ctl_ld(unsigned* p) { return __hip_atomic_load(p, __ATOMIC_RELAXED, __HIP_MEMORY_SCOPE_AGENT); }
__device__ __forceinline__ int queue_pop(unsigned* ctr, lds_t* L) {
    __syncthreads();
    if (threadIdx.x == 0) *(LAS int*)(L + LDS_BYTES - 16) = (int)atomicAdd(ctr, 1u);
    __syncthreads();
    const int item = *(LAS int*)(L + LDS_BYTES - 16);
    __syncthreads();
    return item;
}
__device__ __forceinline__ void copy_drain(const Params& p, lds_t* L, int limit) {
    unsigned* ctr = (unsigned*)(p.ws + W_CTL) + CW_CHUNK;
    for (;;) {
        __syncthreads();
        if (threadIdx.x == 0) { const unsigned cur = ctl_ld(ctr); *(LAS int*)(L + LDS_BYTES - 16) = (cur >= (unsigned)limit) ? NCHUNK : (int)atomicAdd(ctr, 1u); }
        __syncthreads();
        const int idx = *(LAS int*)(L + LDS_BYTES - 16);
        if (idx >= NCHUNK) break;
        kv_copy_chunk(p, idx);
    }
}
__device__ __forceinline__ void copy_fill(const Params& p, lds_t* L, int ph, int my_units, int total_units) {
    unsigned* ctr = (unsigned*)(p.ws + W_CTL) + CW_CHUNK; unsigned* done = (unsigned*)(p.ws + W_CTL) + CW_DONE + 8 * ph;
    if (threadIdx.x == 0) __hip_atomic_fetch_add(done, (unsigned)my_units, __ATOMIC_RELAXED, __HIP_MEMORY_SCOPE_AGENT);
    for (;;) {
        __syncthreads();
        if (threadIdx.x == 0) { const bool stop = ctl_ld(done) >= (unsigned)total_units || ctl_ld(ctr) >= (unsigned)NCHUNK; *(LAS int*)(L + LDS_BYTES - 16) = stop ? NCHUNK : (int)atomicAdd(ctr, 1u); }
        __syncthreads();
        const int idx = *(LAS int*)(L + LDS_BYTES - 16);
        if (idx >= NCHUNK) break;
        kv_copy_chunk(p, idx);
    }
}
__device__ __forceinline__ int count_units(const pg8::StaticOrder& S) { pg8::Unit u; int n = 0; while (S.next(n, u)) ++n; return n; }
__device__ __forceinline__ void phase_prep(const Params& p, lds_t* L) {
    unsigned* ctr = (unsigned*)(p.ws + W_CTL) + CW_Q2;
    for (;;) {
        const int item = queue_pop(ctr, L);
        if (item >= 1024) break;
        dn_prep_task(p, L, item);
    }
    copy_drain(p, L, CH_P2_END);
}
__device__ __forceinline__ void phase_mix(const Params& p, lds_t* L) {
    if (blockIdx.x < NSCAN) dn_scan(p, L, (blockIdx.x & 7) * 8 + (blockIdx.x >> 3));
    unsigned* ctr = (unsigned*)(p.ws + W_CTL) + CW_Q3;
    for (;;) {
        const int item = queue_pop(ctr, L);
        if (item >= IT_END) break;
        if (item < IT_LAST) pdc_item(p);
        else if (item < IT_PKV) kv_lastrow_item(p, item - IT_LAST);
        else if (item < IT_DEC) pkv_chunk(p, item - IT_PKV);
        else if (item < IT_ATT) attn_decode_item(p, L, item - IT_DEC);
        else if (item < IT_REC) attn_prompt_item(p, L, item - IT_ATT);
        else dn_rec_item(p, L, item - IT_REC);
    }
}

#define XB_TMO      128
#define XB_XCNT(j)  (256  + 64 * (j))
#define XB_XSUB(j)  (1280 + 64 * (j))
#define XB_XGEN(j)  (2304 + 64 * (j))
#define XB_TOP      3328
#define XB_TOPGEN   3392
#define XCD_BAR_WORDS 3456
#define XB_SPIN_CAP (1u << 18)
__device__ __forceinline__ unsigned xb_ld(unsigned* p)              { return __hip_atomic_load(p, __ATOMIC_RELAXED, __HIP_MEMORY_SCOPE_AGENT); }
__device__ __forceinline__ unsigned xb_add(unsigned* p, unsigned v) { return __hip_atomic_fetch_add(p, v, __ATOMIC_RELAXED, __HIP_MEMORY_SCOPE_AGENT); }
__device__ __forceinline__ unsigned xb_xcc_id() { return (unsigned)__builtin_amdgcn_s_getreg((3 << 11) | 20) & 0xFu; }
#define XB_SPIN(cond, bar) do { unsigned _sp = 0; while (cond) { __builtin_amdgcn_s_sleep(1); \
    if ((++_sp & 255u) == 0u) { if (xb_ld(&(bar)[XB_TMO])) break; if (_sp > XB_SPIN_CAP) { atomicAdd(&(bar)[XB_TMO], 1u); break; } } } } while (0)
struct XcdBarrier { unsigned* bar; unsigned x; volatile LAS unsigned* st; };
__device__ __forceinline__ XcdBarrier xcd_barrier_post(unsigned* bar, volatile LAS unsigned* st) {
    XcdBarrier b; b.bar = bar; b.x = xb_xcc_id(); b.st = st;
    if (threadIdx.x == 0) (void)xb_add(&bar[XB_XCNT(b.x)], 1u);
    return b;
}
__device__ __forceinline__ void xcd_barrier_complete(unsigned* bar, unsigned x, unsigned& nloc, unsigned& nx) {
    const unsigned G = gridDim.x * gridDim.y * gridDim.z;
    unsigned sum, cnt, mine, sp = 0u;
    for (;;) {
        sum = 0u; cnt = 0u; mine = 0u;
#pragma unroll
        for (unsigned j = 0; j < 16; ++j) { const unsigned c = xb_ld(&bar[XB_XCNT(j)]); sum += c; cnt += (c > 0u) ? 1u : 0u; mine = (j == x) ? c : mine; }
        if (sum == G) break;
        __builtin_amdgcn_s_sleep(1);
        if ((++sp & 255u) == 0u) { if (xb_ld(&bar[XB_TMO])) break; if (sp > XB_SPIN_CAP) { atomicAdd(&bar[XB_TMO], 1u); break; } }
    }
    nloc = mine > 0u ? mine : 1u; nx = cnt > 0u ? cnt : 1u;
}
__device__ __forceinline__ void xcd_barrier(const XcdBarrier& b) {
    asm volatile("s_waitcnt vmcnt(0)" ::: "memory");
    __syncthreads();
    if (threadIdx.x == 0) {
        unsigned* bar = b.bar;
        __builtin_amdgcn_s_waitcnt(0);
        unsigned nloc = b.st[0], nx = b.st[1];
        if (nloc == 0u) { xcd_barrier_complete(bar, b.x, nloc, nx); b.st[0] = nloc; b.st[1] = nx; }
        const unsigned old = xb_add(&bar[XB_XSUB(b.x)], 1u);
        const unsigned gen = old / nloc;
        if (old + 1u == (gen + 1u) * nloc) {
            __builtin_amdgcn_fence(__ATOMIC_RELEASE, "agent");
            asm volatile("s_waitcnt vmcnt(0)" ::: "memory");
            const unsigned og = xb_add(&bar[XB_TOP], 1u);
            const unsigned tg = og / nx;
            if (og + 1u == (tg + 1u) * nx) xb_add(&bar[XB_TOPGEN], 1u);
            else XB_SPIN(xb_ld(&bar[XB_TOPGEN]) == tg, bar);
            __builtin_amdgcn_fence(__ATOMIC_ACQUIRE, "agent");
            xb_add(&bar[XB_XGEN(b.x)], 1u);
            asm volatile("s_waitcnt vmcnt(0)" ::: "memory");
        } else {
            XB_SPIN(xb_ld(&bar[XB_XGEN(b.x)]) == gen, bar);
            __builtin_amdgcn_fence(__ATOMIC_ACQUIRE, "agent");
            asm volatile("s_waitcnt vmcnt(0)" ::: "memory");
        }
    }
    __syncthreads();
}

__global__ void __launch_bounds__(512, 2) fwd_megakernel(Params p) {
    extern __shared__ __attribute__((aligned(16))) unsigned char shm[];
    lds_t* L = (lds_t*)shm;
    cg::grid_group grid = cg::this_grid();
    const int G = gridDim.x, c = blockIdx.x;
    const bf16_t* XB = (const bf16_t*)(p.ws + W_XB);
    bf16_t* PROJ = (bf16_t*)(p.ws + W_PROJ);

    if (threadIdx.x < 4) *(LAS unsigned*)(L + LDS_BYTES - 48 + threadIdx.x * 4) = 0u;
    __syncthreads();
    const XcdBarrier xb = xcd_barrier_post((unsigned*)(p.ws + W_CTL), (volatile LAS unsigned*)(L + LDS_BYTES - 48));
    phase_convert(p, L);
    grid.sync();

    {
        constexpr int NCP1 = 23;
        pg8::StaticOrder S; S.init(MPAD, NPROJ, G - NCP1, c);
        pg8::Gemm g{XB, (const bf16_t*)(p.ws + W_WIN), MPAD, NPROJ, DM};
        pg8::EpiStoreBf16 E{PROJ, NPROJ};
        if (c < G - NCP1) { pg8::gemm_phase(L, g, S, E); copy_fill(p, L, 0, count_units(S), (MPAD / 256) * (NPROJ / 256)); }
        else copy_fill(p, L, 0, 0, (MPAD / 256) * (NPROJ / 256));
    }
    xcd_barrier(xb);
    phase_prep(p, L);
    xcd_barrier(xb);
    phase_mix(p, L);
    xcd_barrier(xb);
    for (int item = c; item < 256; item += G) dn_norm_item(p, item);
    xcd_barrier(xb);
    {
        pg8::StaticOrder S; S.init(MPAD, DM, G, c);
        pg8::Gemm g1{(const bf16_t*)(p.ws + W_OATT), (const bf16_t*)(p.ws + W_WAO), MPAD, DM, 256};
        pg8::EpiGate1 E1{(float*)(p.ws + W_T1), PROJ};
        pg8::gemm_phase(L, g1, S, E1);
        asm volatile("s_waitcnt vmcnt(0)" ::: "memory");
        __syncthreads();
        pg8::Gemm g2{(const bf16_t*)(p.ws + W_ODN), (const bf16_t*)(p.ws + W_WDO), MPAD, DM, 512};
        pg8::EpiGate2 E2{(bf16_t*)(p.ws + W_MRG), (const float*)(p.ws + W_T1), PROJ};
        pg8::gemm_phase(L, g2, S, E2);
        copy_fill(p, L, 1, count_units(S), (MPAD / 256) * (DM / 256));
    }
    xcd_barrier(xb);
    {
        pg8::StaticOrder S; S.init(NPROMPT, DM, G, c);
        pg8::Gemm g{(const bf16_t*)(p.ws + W_MRG), (const bf16_t*)(p.ws + W_WO), NPROMPT, DM, DM};
        pg8::EpiRes E{(float*)(p.ws + W_PRE), p.in[0], p.in[1]};
        pg8::gemm_phase(L, g, S, E);
        {
            pg8::StaticOrder S2; S2.init(256, 4 * DM, G, c);
            pg8::Gemm g2{(const bf16_t*)(p.ws + W_MRG) + (size_t)NPROMPT * DM, (const bf16_t*)(p.ws + W_WO), 256, 4 * DM, 256, DM, 4};
            pg8::EpiAtomic E2{(float*)(p.ws + W_PRE), NPROMPT, 4};
            pg8::gemm_phase(L, g2, S2, E2);
        }
        copy_fill(p, L, 2, 1, 256);
    }
    xcd_barrier(xb);
    phase_ln<false>(p, p.in[16], p.in[17]);
    xcd_barrier(xb);
    {
        constexpr int NCP7 = 17;
        pg8::StaticOrder S; S.init(MPAD, NUP, G - NCP7, c);
        pg8::Gemm g{(const bf16_t*)(p.ws + W_HB), (const bf16_t*)(p.ws + W_WUP), MPAD, NUP, DM};
        pg8::EpiStoreBf16 E{(bf16_t*)(p.ws + W_UP), NUP};
        if (c < G - NCP7) { pg8::gemm_phase(L, g, S, E); copy_fill(p, L, 3, count_units(S), (MPAD / 256) * (NUP / 256)); }
        else copy_fill(p, L, 3, 0, (MPAD / 256) * (NUP / 256));
    }
    xcd_barrier(xb);
    phase_ffn_act(p);
    xcd_barrier(xb);
    {
        pg8::StaticOrder S; S.init(NPROMPT, DM, G, c);
        pg8::Gemm g{(const bf16_t*)(p.ws + W_ACT), (const bf16_t*)(p.ws + W_WDN), NPROMPT, DM, DFF};
        pg8::EpiRes E{(float*)(p.ws + W_PRE), (const float*)(p.ws + W_H), (const float*)(p.ws + W_H) + (size_t)NPROMPT * DM};
        pg8::gemm_phase(L, g, S, E);
        {
            pg8::StaticOrder S2; S2.init(256, 11 * DM, G, c);
            pg8::Gemm g2{(const bf16_t*)(p.ws + W_ACT) + (size_t)NPROMPT * DFF, (const bf16_t*)(p.ws + W_WDN), 256, 11 * DM, 256, DFF, 4};
            pg8::EpiAtomic E2{(float*)(p.ws + W_PRE), NPROMPT, 4};
            pg8::gemm_phase(L, g2, S2, E2);
        }
        copy_fill(p, L, 4, 1, 256);
        copy_drain(p, L, NCHUNK);
    }
    xcd_barrier(xb);
    phase_ln<true>(p, p.in[22], p.in[23]);
}

extern "C" void kernel_launch(void* const* d_in, const int* in_sizes, int n_in, void* d_out, int out_size, void* d_ws, size_t ws_size, hipStream_t stream) {
    static int grid = 0;
    if (grid == 0) {
        if (n_in != 24 || (size_t)out_size != O_END || ws_size < W_END) { fprintf(stderr, "kernel_launch: unexpected shapes (n_in %d out %d ws %zu need %zu)\n", n_in, out_size, ws_size, (size_t)W_END); grid = -1; return; }
        int dev = 0, cus = 0, per_cu = 0;
        hipGetDevice(&dev);
        hipDeviceGetAttribute(&cus, hipDeviceAttributeMultiprocessorCount, dev);
        if (hipFuncSetAttribute((const void*)fwd_megakernel, hipFuncAttributeMaxDynamicSharedMemorySize, LDS_BYTES) != hipSuccess) { fprintf(stderr, "kernel_launch: hipFuncSetAttribute failed\n"); grid = -1; return; }
        if (hipOccupancyMaxActiveBlocksPerMultiprocessor(&per_cu, (const void*)fwd_megakernel, NTHR, LDS_BYTES) != hipSuccess || per_cu < 1) { fprintf(stderr, "kernel_launch: occupancy query says %d\n", per_cu); per_cu = 1; }
        (void)hipGetLastError();
        grid = cus;
    }
    if (grid < 0) return;
    hipMemsetAsync((char*)d_ws + W_CTL, 0, 16384, stream);
    Params p{};
    for (int i = 0; i < 24; ++i) p.in[i] = (const float*)d_in[i];
    p.out = (float*)d_out; p.ws = (unsigned char*)d_ws;
    void* args[] = {&p};
    hipError_t e = hipLaunchCooperativeKernel((const void*)fwd_megakernel, dim3(grid), dim3(NTHR), args, LDS_BYTES, stream);
    if (e != hipSuccess) fprintf(stderr, "cooperative launch failed: %s (grid %d)\n", hipGetErrorString(e), grid);
}
```
